# Optimizing an MI355X kernel written in HIP

```python
import math
import jax, jax.numpy as jnp
from jax import lax
import numpy as np

D_MODEL = 1024
BATCH = 8
SEQ = 4096
DEPTH = 1

HEAD_DIM = 64
N_Q_HEADS = 8
N_KV_HEADS = 2
GQ = N_Q_HEADS // N_KV_HEADS
WINDOW = 128
BLOCK = 128
ROPE_THETA = 10000.0
D_A = N_Q_HEADS * HEAD_DIM
D_KV = N_KV_HEADS * HEAD_DIM

CHUNK = 128
N_GROUPS = 4
D_B = D_MODEL // 2
GROUP_W = D_B // N_GROUPS

EPS = 1e-6
NEG = -1e30

SPLIT_SIZES = [D_A, D_KV, D_KV, D_A,
               D_B, D_B, D_B,
               2 * D_MODEL]
SPLIT_IDX = [int(s) for s in np.cumsum(SPLIT_SIZES)[:-1]]
D_IN = int(sum(SPLIT_SIZES))

kernel_name = "hybrid_swa_sink_gmlp_gated_block"


def _rms(x, g):
    xf = x.astype(jnp.float32)
    y = xf * lax.rsqrt(jnp.mean(xf * xf, axis=-1, keepdims=True) + EPS)
    return (y * g.astype(jnp.float32)).astype(x.dtype)


def _layernorm(x, g, b):
    xf = x.astype(jnp.float32)
    mu = jnp.mean(xf, axis=-1, keepdims=True)
    var = jnp.mean(jnp.square(xf - mu), axis=-1, keepdims=True)
    y = (xf - mu) * lax.rsqrt(var + EPS)
    return (y * g.astype(jnp.float32) + b.astype(jnp.float32)).astype(x.dtype)


def _rope(t, positions):
    half = HEAD_DIM // 2
    inv_freq = ROPE_THETA ** (-jnp.arange(half, dtype=jnp.float32) / half)
    ang = positions.astype(jnp.float32)[..., None] * inv_freq
    cos = jnp.cos(ang)[:, :, None, :]
    sin = jnp.sin(ang)[:, :, None, :]
    tf = t.astype(jnp.float32)
    t1, t2 = tf[..., :half], tf[..., half:]
    out = jnp.concatenate([t1 * cos - t2 * sin, t2 * cos + t1 * sin], axis=-1)
    return out.astype(t.dtype)


def _band(t):
    b, s, h, d = t.shape
    tb = t.reshape(b, s // BLOCK, BLOCK, h, d)
    prev = jnp.pad(tb[:, :-1], ((0, 0), (1, 0), (0, 0), (0, 0), (0, 0)))
    return jnp.concatenate([prev, tb], axis=2)


def _swa_with_sinks(q, k, v, sinks):
    b, s = q.shape[:2]
    nb = s // BLOCK
    qb = q.reshape(b, nb, BLOCK, N_KV_HEADS, GQ, HEAD_DIM)
    kb, vb = _band(k), _band(v)
    scores = jnp.einsum('bnqkgd,bnjkd->bnkgqj', qb, kb).astype(jnp.float32)
    scores = scores * (1.0 / math.sqrt(HEAD_DIM))
    qi = jnp.arange(BLOCK)[:, None]
    kj = jnp.arange(2 * BLOCK)[None, :]
    rel = qi + BLOCK - kj
    in_win = (rel >= 0) & (rel < WINDOW)
    blk = jnp.arange(nb)[:, None, None]
    valid = in_win[None] & ((blk > 0) | (kj[None] >= BLOCK))
    scores = jnp.where(valid[None, :, None, None], scores, NEG)
    sink = sinks.astype(jnp.float32).reshape(N_KV_HEADS, GQ)[None, None, :, :, None, None]
    sink = jnp.broadcast_to(sink, scores.shape[:-1] + (1,))
    probs = jax.nn.softmax(jnp.concatenate([scores, sink], axis=-1), axis=-1)[..., :-1]
    out = jnp.einsum('bnkgqj,bnjkd->bnqkgd', probs.astype(v.dtype), vb)
    return out.reshape(b, s, N_Q_HEADS * HEAD_DIM)


def _chunked_spatial_gating(u, v, ln_g, ln_b, w_s, b_s):
    b, s, _ = v.shape
    nc = s // CHUNK
    vn = _layernorm(v, ln_g, ln_b).reshape(b, nc, CHUNK, N_GROUPS, GROUP_W)
    causal = jnp.tril(jnp.ones((CHUNK, CHUNK), dtype=bool))
    w = jnp.where(causal[None], w_s, jnp.zeros((), w_s.dtype))
    sv = jnp.einsum('gts,bnsgc->bntgc', w, vn) + b_s.T[None, None, :, :, None]
    return u * sv.reshape(b, s, D_B)


def setup_inputs(seed: int = 0) -> dict:
    key = jax.random.key(seed)
    ks = jax.random.split(key, 18)
    f32 = jnp.float32
    nrm = lambda k, shape, s: jax.random.normal(k, shape, f32) * s
    x = jax.random.normal(ks[0], (BATCH, SEQ, D_MODEL), f32)
    c = jax.random.normal(ks[1], (BATCH, D_MODEL), f32)
    positions = jnp.broadcast_to(jnp.arange(SEQ, dtype=jnp.int32), (BATCH, SEQ))
    return {
        "x": x,
        "c": c,
        "positions": positions,
        "w_ada": nrm(ks[2], (DEPTH, D_MODEL, 3 * D_MODEL), 0.5 * D_MODEL ** -0.5),
        "b_ada": nrm(ks[3], (DEPTH, 3 * D_MODEL), 0.02),
        "g_pre": 1.0 + nrm(ks[4], (DEPTH, D_MODEL), 0.05),
        "g_post": 1.0 + nrm(ks[5], (DEPTH, D_MODEL), 0.05),
        "w_in": nrm(ks[6], (DEPTH, D_MODEL, D_IN), D_MODEL ** -0.5),
        "sinks": nrm(ks[7], (DEPTH, N_Q_HEADS), 1.0),
        "ln_v_g": 1.0 + nrm(ks[8], (DEPTH, D_B), 0.05),
        "ln_v_b": nrm(ks[9], (DEPTH, D_B), 0.02),
        "w_s": nrm(ks[10], (DEPTH, N_GROUPS, CHUNK, CHUNK), CHUNK ** -0.5),
        "b_s": 1.0 + nrm(ks[11], (DEPTH, N_GROUPS, CHUNK), 0.1),
        "w_proj_a": nrm(ks[12], (DEPTH, D_A, D_MODEL), D_A ** -0.5),
        "w_proj_b": nrm(ks[13], (DEPTH, D_B, D_MODEL), D_B ** -0.5),
        "w_out": nrm(ks[14], (DEPTH, D_MODEL, D_MODEL), D_MODEL ** -0.5),
    }


def reference(x, c, positions, w_ada, b_ada, g_pre, g_post, w_in, sinks,
              ln_v_g, ln_v_b, w_s, b_s, w_proj_a, w_proj_b, w_out):
    b, s, _ = x.shape
    c_act = jax.nn.silu(c)
    for l in range(DEPTH):
        ada = (c_act @ w_ada[l] + b_ada[l])[:, None, :]
        shift, scale, gate = jnp.split(ada, 3, axis=-1)
        h = _rms(x, g_pre[l]) * (1.0 + scale) + shift

        proj = h @ w_in[l]
        q, k, v, z_a, u_b, v_b, z_b, g_logits = jnp.split(proj, SPLIT_IDX, axis=-1)

        q = _rope(q.reshape(b, s, N_Q_HEADS, HEAD_DIM), positions)
        k = _rope(k.reshape(b, s, N_KV_HEADS, HEAD_DIM), positions)
        v = v.reshape(b, s, N_KV_HEADS, HEAD_DIM)
        y_a = _swa_with_sinks(q, k, v, sinks[l]) * jax.nn.silu(z_a)

        y_b = _chunked_spatial_gating(jax.nn.gelu(u_b, approximate=False),
                                      jax.nn.gelu(v_b, approximate=False),
                                      ln_v_g[l], ln_v_b[l], w_s[l], b_s[l])
        y_b = y_b * jax.nn.silu(z_b)

        gates = jax.nn.sigmoid(g_logits)
        gate_a, gate_b = jnp.split(gates, 2, axis=-1)
        merged = gate_a * (y_a @ w_proj_a[l]) + gate_b * (y_b @ w_proj_b[l])
        y = merged @ w_out[l]

        x = x + gate * _rms(y, g_post[l])
    return x
```

```cpp
#include <hip/hip_runtime.h>
#include <cstdio>
#include <cstdint>
#include <cmath>
#ifndef MK_N_LAUNCHES
#define MK_N_LAUNCHES 1
#endif
namespace pg8 {
#define PG8_LAS __attribute__((address_space(3)))
typedef unsigned short bf16_t;
typedef short bf16x8 __attribute__((ext_vector_type(8)));
typedef float f32x4 __attribute__((ext_vector_type(4)));
typedef unsigned u32x4 __attribute__((ext_vector_type(4)));
constexpr int BM = 256, BK = 64, HALF = 128, HTB = HALF * BK * 2  , STAGE_BYTES = 8 * HTB, NXCD = 8, WGM = 8;

__host__ __device__ __forceinline__ int lds_byte(int r, int c) { const int st = (r >> 4) * 2 + (c >> 5), rr = r & 15, cc = c & 31, ob = rr * 64 + cc * 2; return st * 1024 + (ob ^ (((ob >> 9) & 1) << 5)); }
__host__ __device__ __forceinline__ void stage_rc(int b, int& R, int& C) { const int st = b / 1024, sb = b % 1024, swz = sb ^ (((sb >> 9) & 1) << 5); R = (st >> 1) * 16 + swz / 64; C = (st & 1) * 32 + (swz % 64) / 2; }
__host__ __device__ __forceinline__ int perm32(int rho) { const int n = rho >> 4, i = rho & 15; return 8 * (i >> 2) + 4 * n + (i & 3); }

struct Unit { int pm, pn; };
struct Gemm { const bf16_t* A; const bf16_t* Bt; int M, N, K; };

struct StaticOrder {
    int nM, nN, nwg, G, c;
    __host__ __device__ void init(int M, int N, int G_, int c_) { nM = M / BM; nN = N / BM; nwg = nM * nN; G = G_; c = c_; }
    __host__ __device__ bool next(int i, Unit& u) const {
        const long L = (long)i * G + c; if (L >= nwg) return false;
        int wgid = (int)L; { const int q = nwg / NXCD, r = nwg % NXCD, xcd = wgid % NXCD, off = wgid / NXCD; wgid = (xcd < r ? xcd * (q + 1) : r * (q + 1) + (xcd - r) * q) + off; }
        const int nig = WGM * nN, gid = wgid / nig, fm = gid * WGM, gsz = (nM - fm) < WGM ? (nM - fm) : WGM;
        u.pm = fm + ((wgid % nig) % gsz); u.pn = (wgid % nig) / gsz; return true;
    }
    __device__ __forceinline__ void a_ready(const Unit&) const {}
    __device__ __forceinline__ void done(const Unit&) const {}
};

typedef float f32x2c __attribute__((ext_vector_type(2))); typedef __bf16 bf16x2c __attribute__((ext_vector_type(2)));
__device__ __forceinline__ unsigned cvt_pk_bf16(float lo, float hi) { f32x2c v = {lo, hi}; bf16x2c b = __builtin_convertvector(v, bf16x2c); return __builtin_bit_cast(unsigned, b); }
typedef float f32x2 __attribute__((ext_vector_type(2)));
__device__ __forceinline__ f32x2 gelu_pk(f32x2 v) {
    const f32x2 av = __builtin_elementwise_abs(v), d = av * 0.2316418882f + 1.0f;
    f32x2 t; t.x = __builtin_amdgcn_rcpf(d.x); t.y = __builtin_amdgcn_rcpf(d.y);
    f32x2 q = t * 0.5307027145f + (-0.7265760135f); q = q * t + 0.7107068705f; q = q * t + (-0.142248368f); q = q * t + 0.127414796f; q = q * t;
    const f32x2 s = (v * v) * (-0.72134752044f);
    f32x2 e; e.x = __builtin_amdgcn_exp2f(s.x); e.y = __builtin_amdgcn_exp2f(s.y);
    const f32x2 m = v * (q * e), r = v - m;
    f32x2 o; o.x = v.x < 0.f ? m.x : r.x; o.y = v.y < 0.f ? m.y : r.y; return o;
}

__device__ __forceinline__ float sigm(float v) { return __builtin_amdgcn_rcpf(1.0f + __builtin_amdgcn_exp2f(-1.4426950408889634f * v)); }
__device__ __forceinline__ f32x4 silu4(f32x4 v) { f32x4 o; o[0] = v[0] * sigm(v[0]); o[1] = v[1] * sigm(v[1]); o[2] = v[2] * sigm(v[2]); o[3] = v[3] * sigm(v[3]); return o; }
__device__ __forceinline__ f32x4 sigm4(f32x4 v) { f32x4 o; o[0] = sigm(v[0]); o[1] = sigm(v[1]); o[2] = sigm(v[2]); o[3] = sigm(v[3]); return o; }
__device__ __forceinline__ f32x4 gelu4(f32x4 v) { const f32x2 a = gelu_pk((f32x2){v[0], v[1]}), b = gelu_pk((f32x2){v[2], v[3]}); return (f32x4){a.x, a.y, b.x, b.y}; }
__device__ __forceinline__ u32x4 pack8(f32x4 a, f32x4 b) { u32x4 w; w.x = cvt_pk_bf16(a[0], a[1]); w.y = cvt_pk_bf16(a[2], a[3]); w.z = cvt_pk_bf16(b[0], b[1]); w.w = cvt_pk_bf16(b[2], b[3]); return w; }
__device__ __forceinline__ float bf_lo(unsigned w) { return __uint_as_float(w << 16); }
__device__ __forceinline__ float bf_hi(unsigned w) { return __uint_as_float(w & 0xffff0000u); }

constexpr float QSCALE = 0.125f * 1.4426950408889634f;

struct EpiProj {
    static constexpr bool PERM = true, AFTER_DRAIN = false, MIDK = false;
    bf16_t *QKV, *ZA, *UZ, *VG, *G; const float *COS, *SIN;
    __device__ __forceinline__ void mid(f32x4 (&)[2][2][4][2], const Unit&, int, int, int, int) const {}
    __device__ __forceinline__ void operator()(const f32x4 (&acc)[2][2][4][2], const Unit& u, int wr, int wc, int fr, int fq) const {
        asm volatile("s_nop 7\n\ts_nop 7\n\ts_nop 3" : "+v"(fr), "+v"(fq));
        const int pn = u.pn, row0 = u.pm * BM + wr * 64 + fr, p0 = wc * 32 + 8 * fq;
#if defined(DBG_TILEMASK)
        { const int ty = pn < 2 ? 0 : pn == 2 ? 1 : pn < 5 ? 2 : pn < 9 ? 3 : pn < 11 ? 4 : 5; if (!((DBG_TILEMASK >> ty) & 1)) return; }
#if defined(DBG_FIRSTONLY)
        { StaticOrder S0; S0.init(32768, 4864, (int)gridDim.x, (int)blockIdx.x); Unit u0; S0.next(DBG_FIRSTONLY, u0); if (!(u0.pm == u.pm && u0.pn == u.pn)) return; }
#endif
#endif
        if (pn < 2 || (pn == 2 && wc < 2)) {
            const int colbase = (pn < 2 ? (4 * pn + wc) * 64 : 512 + wc * 64) + 8 * fq; const float qs = pn < 2 ? QSCALE : 1.0f;
#pragma unroll
            for (int ai = 0; ai < 2; ++ai)
#pragma unroll
                for (int m = 0; m < 4; ++m) { const int row = row0 + ai * HALF + m * 16;
                    const f32x4 c0 = *(const f32x4*)(COS + (size_t)row * 32 + 8 * fq), c1 = *(const f32x4*)(COS + (size_t)row * 32 + 8 * fq + 4);
                    const f32x4 s0 = *(const f32x4*)(SIN + (size_t)row * 32 + 8 * fq), s1 = *(const f32x4*)(SIN + (size_t)row * 32 + 8 * fq + 4);
                    const f32x4 a0 = acc[ai][0][m][0], a1 = acc[ai][0][m][1], b0 = acc[ai][1][m][0], b1 = acc[ai][1][m][1];
                    const f32x4 o10 = (a0 * c0 - b0 * s0) * qs, o11 = (a1 * c1 - b1 * s1) * qs, o20 = (b0 * c0 + a0 * s0) * qs, o21 = (b1 * c1 + a1 * s1) * qs;
                    bf16_t* rp = QKV + (size_t)row * 768 + colbase;
                    *(u32x4*)rp = pack8(o10, o11); *(u32x4*)(rp + 32) = pack8(o20, o21); }
        } else if (pn == 2) {
            const int colbase = 640 + (wc - 2) * 32 + 8 * fq;
#pragma unroll
            for (int ai = 0; ai < 2; ++ai)
#pragma unroll
                for (int m = 0; m < 4; ++m) { bf16_t* rp = QKV + (size_t)(row0 + ai * HALF + m * 16) * 768 + colbase;
#pragma unroll
                    for (int bj = 0; bj < 2; ++bj) *(u32x4*)(rp + bj * 64) = pack8(acc[ai][bj][m][0], acc[ai][bj][m][1]); }
        } else if (pn < 5) {
#pragma unroll
            for (int ai = 0; ai < 2; ++ai)
#pragma unroll
                for (int m = 0; m < 4; ++m) { bf16_t* rp = ZA + (size_t)(row0 + ai * HALF + m * 16) * 512 + (pn - 3) * 256 + p0;
#pragma unroll
                    for (int bj = 0; bj < 2; ++bj) *(u32x4*)(rp + bj * HALF) = pack8(silu4(acc[ai][bj][m][0]), silu4(acc[ai][bj][m][1])); }
        } else if (pn < 9) {
#pragma unroll
            for (int ai = 0; ai < 2; ++ai)
#pragma unroll
                for (int m = 0; m < 4; ++m) { bf16_t* rp = UZ + (size_t)(row0 + ai * HALF + m * 16) * 512 + (pn - 5) * 128 + p0;
                    *(u32x4*)rp = pack8(gelu4(acc[ai][0][m][0]) * silu4(acc[ai][1][m][0]), gelu4(acc[ai][0][m][1]) * silu4(acc[ai][1][m][1])); }
        } else if (pn < 11) {
#pragma unroll
            for (int ai = 0; ai < 2; ++ai)
#pragma unroll
                for (int m = 0; m < 4; ++m) { bf16_t* rp = VG + (size_t)(row0 + ai * HALF + m * 16) * 512 + (pn - 9) * 256 + p0;
#pragma unroll
                    for (int bj = 0; bj < 2; ++bj) *(u32x4*)(rp + bj * HALF) = pack8(gelu4(acc[ai][bj][m][0]), gelu4(acc[ai][bj][m][1])); }
        } else {
#pragma unroll
            for (int ai = 0; ai < 2; ++ai)
#pragma unroll
                for (int m = 0; m < 4; ++m) { bf16_t* rp = G + (size_t)(row0 + ai * HALF + m * 16) * 2048 + (pn - 11) * 256 + p0;
#pragma unroll
                    for (int bj = 0; bj < 2; ++bj) *(u32x4*)(rp + bj * HALF) = pack8(sigm4(acc[ai][bj][m][0]), sigm4(acc[ai][bj][m][1])); }
        }
    }
};

struct EpiMerge {
    static constexpr bool PERM = true, AFTER_DRAIN = false, MIDK = true;
    const bf16_t* G; bf16_t* O;
    __device__ __forceinline__ void mid(f32x4 (&acc)[2][2][4][2], const Unit& u, int wr, int wc, int fr, int fq) const {
        asm volatile("s_nop 7\n\ts_nop 7\n\ts_nop 3" : "+v"(fr), "+v"(fq));
        const int row0 = u.pm * BM + wr * 64 + fr, col0 = u.pn * BM + wc * 32 + 8 * fq;
#pragma unroll
        for (int ai = 0; ai < 2; ++ai)
#pragma unroll
            for (int m = 0; m < 4; ++m) { const bf16_t* gp = G + (size_t)(row0 + ai * HALF + m * 16) * 2048 + col0;
#pragma unroll
                for (int bj = 0; bj < 2; ++bj) { const u32x4 ga = *(const u32x4*)(gp + bj * HALF), gb = *(const u32x4*)(gp + 1024 + bj * HALF);
                    f32x4 r0, r1;
                    r0[0] = bf_lo(ga.x) * __builtin_amdgcn_rcpf(fmaxf(bf_lo(gb.x), 1e-30f)); r0[1] = bf_hi(ga.x) * __builtin_amdgcn_rcpf(fmaxf(bf_hi(gb.x), 1e-30f));
                    r0[2] = bf_lo(ga.y) * __builtin_amdgcn_rcpf(fmaxf(bf_lo(gb.y), 1e-30f)); r0[3] = bf_hi(ga.y) * __builtin_amdgcn_rcpf(fmaxf(bf_hi(gb.y), 1e-30f));
                    r1[0] = bf_lo(ga.z) * __builtin_amdgcn_rcpf(fmaxf(bf_lo(gb.z), 1e-30f)); r1[1] = bf_hi(ga.z) * __builtin_amdgcn_rcpf(fmaxf(bf_hi(gb.z), 1e-30f));
                    r1[2] = bf_lo(ga.w) * __builtin_amdgcn_rcpf(fmaxf(bf_lo(gb.w), 1e-30f)); r1[3] = bf_hi(ga.w) * __builtin_amdgcn_rcpf(fmaxf(bf_hi(gb.w), 1e-30f));
                    acc[ai][bj][m][0] = acc[ai][bj][m][0] * r0; acc[ai][bj][m][1] = acc[ai][bj][m][1] * r1; } }
    }
    __device__ __forceinline__ void operator()(const f32x4 (&acc)[2][2][4][2], const Unit& u, int wr, int wc, int fr, int fq) const {
        asm volatile("s_nop 7\n\ts_nop 7\n\ts_nop 3" : "+v"(fr), "+v"(fq));
        const int row0 = u.pm * BM + wr * 64 + fr, col0 = u.pn * BM + wc * 32 + 8 * fq;
#pragma unroll
        for (int ai = 0; ai < 2; ++ai)
#pragma unroll
            for (int m = 0; m < 4; ++m) { const size_t row = (size_t)(row0 + ai * HALF + m * 16);
#pragma unroll
                for (int bj = 0; bj < 2; ++bj) { const u32x4 gb = *(const u32x4*)(G + row * 2048 + 1024 + col0 + bj * HALF);
                    const f32x4 g0 = (f32x4){bf_lo(gb.x), bf_hi(gb.x), bf_lo(gb.y), bf_hi(gb.y)}, g1 = (f32x4){bf_lo(gb.z), bf_hi(gb.z), bf_lo(gb.w), bf_hi(gb.w)};
                    *(u32x4*)(O + row * 1024 + col0 + bj * HALF) = pack8(acc[ai][bj][m][0] * g0, acc[ai][bj][m][1] * g1); } }
    }
};

struct EpiY {
    static constexpr bool PERM = true, AFTER_DRAIN = false, MIDK = false;
    bf16_t* O; float* RSS;
    __device__ __forceinline__ void mid(f32x4 (&)[2][2][4][2], const Unit&, int, int, int, int) const {}
    __device__ __forceinline__ void operator()(const f32x4 (&acc)[2][2][4][2], const Unit& u, int wr, int wc, int fr, int fq) const {
        asm volatile("s_nop 7\n\ts_nop 7\n\ts_nop 3" : "+v"(fr), "+v"(fq));
        const int row0 = u.pm * BM + wr * 64 + fr, col0 = u.pn * BM + wc * 32 + 8 * fq;
#pragma unroll
        for (int ai = 0; ai < 2; ++ai)
#pragma unroll
            for (int m = 0; m < 4; ++m) { const size_t row = (size_t)(row0 + ai * HALF + m * 16); float q = 0.f;
#pragma unroll
                for (int bj = 0; bj < 2; ++bj) { const f32x4 a = acc[ai][bj][m][0], b = acc[ai][bj][m][1];
                    q += (a[0] * a[0] + a[1] * a[1]) + (a[2] * a[2] + a[3] * a[3]) + (b[0] * b[0] + b[1] * b[1]) + (b[2] * b[2] + b[3] * b[3]);
                    *(u32x4*)(O + row * 1024 + col0 + bj * HALF) = pack8(a, b); }
                q += __shfl_xor(q, 16); q += __shfl_xor(q, 32);
                if (fq == 0) RSS[row * 16 + u.pn * 4 + wc] = q; }
    }
};
template <class Epi, class Sched, bool ALIGN_EPI = false, bool SP2 = false>
__device__ __forceinline__ void gemm_phase(PG8_LAS unsigned char* lds, const Gemm g, const Sched& S, const Epi& E) {
    int tid_ = threadIdx.x; asm volatile("" : "+v"(tid_));
    const int tid = tid_, wid = __builtin_amdgcn_readfirstlane(tid >> 6), lane = tid & 63, wr = wid >> 2, wc = wid & 3, fr = lane & 15, fq = lane >> 4;
    const int K = g.K, nt = K / BK;
    unsigned voffA[2], voffB[2];
#pragma unroll
    for (int i = 0; i < 2; ++i) { int R, C; stage_rc(tid * 16 + i * 8192, R, C); const int Rb = Epi::PERM ? ((R & ~31) + perm32(R & 31)) : R;
        voffA[i] = (unsigned)(R * K + C) * 2u; voffB[i] = (unsigned)(Rb * K + C) * 2u; }
    const size_t kstep = (size_t)(BK * 2);
    const size_t hstep = (size_t)HALF * K * 2;
    const size_t tstep = 2 * hstep;
    const unsigned ldsw = (unsigned)wid * 1024u;
    const int aoff = lds_byte(wr * 64 + fr, fq * 8), boff = lds_byte(wc * 32 + fr, fq * 8);
#define PG8_SA(b, h) (((b) * 2 + (h)) * HTB)
#define PG8_SB(b, h) ((4 + (b) * 2 + (h)) * HTB)
#define PG8_STAGE(bufoff, gbase, voff) do { _Pragma("unroll") for (int _i = 0; _i < 2; ++_i) \
        __builtin_amdgcn_global_load_lds((const unsigned*)((const char*)(gbase) + (voff)[_i]), (PG8_LAS unsigned*)(lds + (bufoff) + ldsw + _i * 8192), 16, 0, 0); } while (0)
#define PG8_LDA(dst, b, h) do { _Pragma("unroll") for (int m = 0; m < 4; ++m) _Pragma("unroll") for (int k = 0; k < 2; ++k) dst[m][k] = *(const PG8_LAS bf16x8*)(lds + PG8_SA(b, h) + aoff + m * 2048 + k * 1024); } while (0)
#define PG8_LDB(dst, b, h) do { _Pragma("unroll") for (int n = 0; n < 2; ++n) _Pragma("unroll") for (int k = 0; k < 2; ++k) dst[n][k] = *(const PG8_LAS bf16x8*)(lds + PG8_SB(b, h) + boff + n * 2048 + k * 1024); } while (0)
#define PG8_MMA(ai, bj, At, Bt) do { __builtin_amdgcn_s_setprio(1); _Pragma("unroll") for (int m = 0; m < 4; ++m) _Pragma("unroll") for (int n = 0; n < 2; ++n) _Pragma("unroll") for (int k = 0; k < 2; ++k) \
        acc[ai][bj][m][n] = __builtin_amdgcn_mfma_f32_16x16x32_bf16(Bt[n][k], At[m][k], acc[ai][bj][m][n], 0, 0, 0); __builtin_amdgcn_s_setprio(0); } while (0)
#define PG8_WAIT_V(n) asm volatile("s_waitcnt vmcnt(" #n ")" ::: "memory")
#define PG8_WAIT_L(n) asm volatile("s_waitcnt lgkmcnt(" #n ")" ::: "memory")
#define PG8_BAR __builtin_amdgcn_s_barrier()
#define PG8_SCHED __builtin_amdgcn_sched_barrier(0)
    Unit cur, nxt; int ui = 0;
    if (!S.next(0, cur)) return;
    f32x4 acc[2][2][4][2];
#pragma unroll
    for (int a = 0; a < 2; ++a)
#pragma unroll
        for (int b = 0; b < 2; ++b)
#pragma unroll
            for (int m = 0; m < 4; ++m)
#pragma unroll
                for (int n = 0; n < 2; ++n) acc[a][b][m][n] = (f32x4){0.f, 0.f, 0.f, 0.f};
    bf16x8 At[4][2], B0[2][2], B1[2][2];
    const char* cA = (const char*)g.A + (size_t)cur.pm * tstep; const char* cB = (const char*)g.Bt + (size_t)cur.pn * tstep;
    S.a_ready(cur);
    if constexpr (SP2) {
        PG8_STAGE(PG8_SB(0, 0), cB, voffB); PG8_STAGE(PG8_SB(0, 1), cB + hstep, voffB); PG8_STAGE(PG8_SA(0, 0), cA, voffA); PG8_STAGE(PG8_SA(0, 1), cA + hstep, voffA);
        if (wr == 1) PG8_BAR;
        PG8_WAIT_V(2); PG8_BAR;
        PG8_STAGE(PG8_SB(1, 0), cB + kstep, voffB); PG8_STAGE(PG8_SA(1, 0), cA + kstep, voffA); PG8_STAGE(PG8_SB(1, 1), cB + hstep + kstep, voffB);
        PG8_WAIT_V(6); PG8_BAR;
    } else {
        PG8_STAGE(PG8_SB(0, 0), cB, voffB); PG8_STAGE(PG8_SA(0, 0), cA, voffA); PG8_STAGE(PG8_SB(0, 1), cB + hstep, voffB); PG8_STAGE(PG8_SA(0, 1), cA + hstep, voffA);
        if (wr == 1) PG8_BAR;
        PG8_WAIT_V(4); PG8_BAR;
        PG8_STAGE(PG8_SB(1, 0), cB + kstep, voffB); PG8_STAGE(PG8_SA(1, 0), cA + kstep, voffA); PG8_STAGE(PG8_SB(1, 1), cB + hstep + kstep, voffB);
        PG8_WAIT_V(6); PG8_BAR;
    }
    for (;;) {
        const bool has_next = S.next(ui + 1, nxt);
        const char* nA = has_next ? (const char*)g.A + (size_t)nxt.pm * tstep : cA; const char* nB = has_next ? (const char*)g.Bt + (size_t)nxt.pn * tstep : cB;
        for (int t = 0; t < nt; t += 2) {
            if constexpr (Epi::MIDK) { if (t == (nt >> 1)) E.mid(acc, cur, wr, wc, fr, fq); }
            const bool last = (t == nt - 2);
            const char* a1 = cA + (size_t)(t + 1) * kstep;
            const char* a2 = last ? nA : cA + (size_t)(t + 2) * kstep; const char* b2 = last ? nB : cB + (size_t)(t + 2) * kstep;
            const char* a3 = a2 + kstep; const char* b3 = b2 + kstep;
            if (last && has_next) S.a_ready(nxt);
            if constexpr (SP2) {
            PG8_LDB(B0, 0, 0); PG8_LDB(B1, 0, 1); PG8_SCHED; PG8_LDA(At, 0, 0); PG8_STAGE(PG8_SA(1, 1), a1 + hstep, voffA);
            PG8_WAIT_V(8); PG8_WAIT_L(0); PG8_BAR; PG8_MMA(0, 0, At, B0); PG8_MMA(0, 1, At, B1); PG8_BAR; PG8_SCHED;
            PG8_LDA(At, 0, 1); PG8_STAGE(PG8_SB(0, 0), b2, voffB); PG8_STAGE(PG8_SB(0, 1), b2 + hstep, voffB); PG8_STAGE(PG8_SA(0, 0), a2, voffA);
            PG8_WAIT_V(8); PG8_WAIT_L(0); PG8_BAR; PG8_MMA(1, 0, At, B0); PG8_MMA(1, 1, At, B1); PG8_BAR; PG8_SCHED;
            PG8_LDB(B0, 1, 0); PG8_LDB(B1, 1, 1); PG8_SCHED; PG8_LDA(At, 1, 0); PG8_STAGE(PG8_SA(0, 1), a2 + hstep, voffA);
            PG8_WAIT_V(8); PG8_WAIT_L(0); PG8_BAR; PG8_MMA(0, 0, At, B0); PG8_MMA(0, 1, At, B1); PG8_BAR; PG8_SCHED;
            PG8_LDA(At, 1, 1); PG8_STAGE(PG8_SB(1, 0), b3, voffB); PG8_STAGE(PG8_SB(1, 1), b3 + hstep, voffB); PG8_STAGE(PG8_SA(1, 0), a3, voffA);
            PG8_WAIT_V(8); PG8_WAIT_L(0); PG8_BAR; PG8_MMA(1, 0, At, B0); PG8_MMA(1, 1, At, B1); PG8_BAR; PG8_SCHED;
            } else {
            PG8_LDB(B0, 0, 0); PG8_SCHED; PG8_LDA(At, 0, 0); PG8_STAGE(PG8_SA(1, 1), a1 + hstep, voffA);
            PG8_WAIT_L(8); PG8_BAR; PG8_WAIT_L(0); PG8_MMA(0, 0, At, B0); PG8_BAR; PG8_SCHED;
            PG8_LDB(B1, 0, 1); PG8_STAGE(PG8_SB(0, 0), b2, voffB);
            PG8_BAR; PG8_WAIT_L(0); PG8_MMA(0, 1, At, B1); PG8_BAR;
            PG8_LDA(At, 0, 1); PG8_STAGE(PG8_SA(0, 0), a2, voffA);
            PG8_BAR; PG8_WAIT_L(0); PG8_MMA(1, 0, At, B0); PG8_BAR; PG8_SCHED;
            PG8_STAGE(PG8_SB(0, 1), b2 + hstep, voffB);
            PG8_WAIT_V(6); PG8_BAR; PG8_MMA(1, 1, At, B1); PG8_BAR;
            PG8_LDB(B0, 1, 0); PG8_SCHED; PG8_LDA(At, 1, 0); PG8_STAGE(PG8_SA(0, 1), a2 + hstep, voffA);
            PG8_WAIT_L(8); PG8_BAR; PG8_WAIT_L(0); PG8_MMA(0, 0, At, B0); PG8_BAR; PG8_SCHED;
            PG8_LDB(B1, 1, 1); PG8_STAGE(PG8_SB(1, 0), b3, voffB);
            PG8_BAR; PG8_WAIT_L(0); PG8_MMA(0, 1, At, B1); PG8_BAR;
            PG8_LDA(At, 1, 1); PG8_STAGE(PG8_SA(1, 0), a3, voffA);
            PG8_BAR; PG8_WAIT_L(0); PG8_MMA(1, 0, At, B0); PG8_BAR; PG8_SCHED;
            PG8_STAGE(PG8_SB(1, 1), b3 + hstep, voffB);
            PG8_WAIT_V(6); PG8_BAR; PG8_MMA(1, 1, At, B1); PG8_BAR;
            }
        }
        if constexpr (ALIGN_EPI) { if (wr == 0) PG8_BAR; }
        if constexpr (!Epi::AFTER_DRAIN) { E(acc, cur, wr, wc, fr, fq); S.done(cur); }
        if (!has_next) break;
#pragma unroll
        for (int a = 0; a < 2; ++a)
#pragma unroll
            for (int b = 0; b < 2; ++b)
#pragma unroll
                for (int m = 0; m < 4; ++m)
#pragma unroll
                    for (int n = 0; n < 2; ++n) acc[a][b][m][n] = (f32x4){0.f, 0.f, 0.f, 0.f};
        cur = nxt; cA = nA; cB = nB; ++ui;
        if constexpr (ALIGN_EPI) { if (wr == 1) PG8_BAR; }
    }
    PG8_WAIT_V(0);
    if constexpr (!ALIGN_EPI) { if (wr == 0) PG8_BAR; }
    PG8_BAR;
    if constexpr (Epi::AFTER_DRAIN) { E.fused(acc, cur, wr, wc, fr, fq, lds, wid, lane); S.done(cur); }
#undef PG8_SA
#undef PG8_SB
#undef PG8_STAGE
#undef PG8_LDA
#undef PG8_LDB
#undef PG8_MMA
#undef PG8_WAIT_V
#undef PG8_WAIT_L
#undef PG8_BAR
#undef PG8_SCHED
}
}
#define GAS __attribute__((address_space(1)))
#define LAS __attribute__((address_space(3)))
typedef unsigned short bf16;
typedef unsigned v4u __attribute__((ext_vector_type(4)));
typedef float f32x4 __attribute__((ext_vector_type(4)));
typedef short bf16x8 __attribute__((ext_vector_type(8)));
typedef GAS unsigned gu32;
typedef GAS unsigned long long gu64;
#define RLX_AGENT __ATOMIC_RELAXED, __HIP_MEMORY_SCOPE_AGENT
#define LDS_WAIT() asm volatile("s_waitcnt lgkmcnt(0)" ::: "memory")
#define VM_WAIT() asm volatile("s_waitcnt vmcnt(0)" ::: "memory")
__device__ __forceinline__ unsigned long long rt() { return __builtin_amdgcn_s_memrealtime(); }
__device__ __forceinline__ unsigned f2bf(float f) { unsigned u = __builtin_bit_cast(unsigned, f); return (u + 0x7fffu + ((u >> 16) & 1u)) >> 16; }
__device__ __forceinline__ unsigned pk2(float lo, float hi) { return f2bf(lo) | (f2bf(hi) << 16); }

#define XB_TMO      128
#define XB_XCNT(j)  (256  + 64 * (j))
#define XB_XSUB(j)  (1280 + 64 * (j))
#define XB_XGEN(j)  (2304 + 64 * (j))
#define XB_TOP      3328
#define XB_TOPGEN   3392
#define XCD_BAR_WORDS 3456
#define XB_SPIN_CAP (1u << 18)

__device__ __forceinline__ unsigned xb_ld(unsigned* p)              { return __hip_atomic_load(p, __ATOMIC_RELAXED, __HIP_MEMORY_SCOPE_AGENT); }
__device__ __forceinline__ unsigned xb_add(unsigned* p, unsigned v) { return __hip_atomic_fetch_add(p, v, __ATOMIC_RELAXED, __HIP_MEMORY_SCOPE_AGENT); }
__device__ __forceinline__ unsigned xb_xcc_id() { return (unsigned)__builtin_amdgcn_s_getreg((3 << 11) | 20) & 0xFu; }
#define XB_SPIN(cond, bar) do { unsigned _sp = 0; while (cond) { __builtin_amdgcn_s_sleep(1); \
    if ((++_sp & 255u) == 0u) { if (xb_ld(&(bar)[XB_TMO])) break; if (_sp > XB_SPIN_CAP) { atomicAdd(&(bar)[XB_TMO], 1u); break; } } } } while (0)

struct XcdBarrier {
    unsigned* bar; unsigned x;
    volatile LAS unsigned* st;
};

__device__ __forceinline__ XcdBarrier xcd_barrier_post(unsigned* bar, volatile LAS unsigned* st) {
    XcdBarrier b; b.bar = bar; b.x = xb_xcc_id(); b.st = st;
    if (threadIdx.x == 0) (void)xb_add(&bar[XB_XCNT(b.x)], 1u);
    return b;
}
__device__ __forceinline__ void xcd_barrier_complete(unsigned* bar, unsigned x, unsigned& nloc, unsigned& nx) {
    const unsigned G = gridDim.x * gridDim.y * gridDim.z;
    unsigned sum, cnt, mine, sp = 0u;
    for (;;) {
        sum = 0u; cnt = 0u; mine = 0u;
#pragma unroll
        for (unsigned j = 0; j < 16; ++j) { const unsigned c = xb_ld(&bar[XB_XCNT(j)]); sum += c; cnt += (c > 0u) ? 1u : 0u; mine = (j == x) ? c : mine; }
        if (sum == G) break;
        __builtin_amdgcn_s_sleep(1);
        if ((++sp & 255u) == 0u) { if (xb_ld(&bar[XB_TMO])) break; if (sp > XB_SPIN_CAP) { atomicAdd(&bar[XB_TMO], 1u); break; } }
    }
    nloc = mine > 0u ? mine : 1u; nx = cnt > 0u ? cnt : 1u;
}

__device__ __forceinline__ void xcd_barrier(const XcdBarrier& b) {
    asm volatile("s_waitcnt vmcnt(0)" ::: "memory");
    __syncthreads();
    if (threadIdx.x == 0) {
        unsigned* bar = b.bar;
        __builtin_amdgcn_s_waitcnt(0);
        unsigned nloc = b.st[0], nx = b.st[1];
        if (nloc == 0u) { xcd_barrier_complete(bar, b.x, nloc, nx); b.st[0] = nloc; b.st[1] = nx; }
        const unsigned old = xb_add(&bar[XB_XSUB(b.x)], 1u);
        const unsigned gen = old / nloc;
        if (old + 1u == (gen + 1u) * nloc) {
            __builtin_amdgcn_fence(__ATOMIC_RELEASE, "agent");
            asm volatile("s_waitcnt vmcnt(0)" ::: "memory");
            const unsigned og = xb_add(&bar[XB_TOP], 1u);
            const unsigned tg = og / nx;
            if (og + 1u == (tg + 1u) * nx) xb_add(&bar[XB_TOPGEN], 1u);
            else XB_SPIN(xb_ld(&bar[XB_TOPGEN]) == tg, bar);
            __builtin_amdgcn_fence(__ATOMIC_ACQUIRE, "agent");
            xb_add(&bar[XB_XGEN(b.x)], 1u);
            asm volatile("s_waitcnt vmcnt(0)" ::: "memory");
        } else {
            XB_SPIN(xb_ld(&bar[XB_XGEN(b.x)]) == gen, bar);
            __builtin_amdgcn_fence(__ATOMIC_ACQUIRE, "agent");
            asm volatile("s_waitcnt vmcnt(0)" ::: "memory");
        }
    }
    __syncthreads();
}

constexpr int NWAVES = 8;
constexpr int N_LAUNCHES = MK_N_LAUNCHES;
constexpr int PER_PHASE = 7;
constexpr int BATCH = 8, SEQ = 4096, DM = 1024, M = BATCH * SEQ;
constexpr int D_IN = 4864, NBLK = M / 128;
constexpr float EPS = 1e-6f;

constexpr size_t MiB = 1u << 20;
constexpr size_t WS_CTL = 0, CTL_ZERO_BYTES = 64 * 1024;
constexpr size_t WS_WIN = 2 * MiB;
constexpr size_t WS_WP = 12 * MiB;
constexpr size_t WS_WO = 14 * MiB;
constexpr size_t WS_WS = 16 * MiB;
constexpr size_t WS_ADA = 16 * MiB + 512 * 1024;
constexpr size_t WS_COS = 18 * MiB, WS_SIN = 22 * MiB;
constexpr size_t WS_RSS = 26 * MiB;
constexpr size_t WS_H = 32 * MiB;
constexpr size_t WS_QKV = 96 * MiB;
constexpr size_t WS_ZA = 144 * MiB;
constexpr size_t WS_UZ = 176 * MiB;
constexpr size_t WS_VG = 208 * MiB;
constexpr size_t WS_G = 240 * MiB;
constexpr size_t WS_MRG = 368 * MiB;
constexpr size_t WS_END = 432 * MiB;
constexpr int CW_BAR = 1024;

constexpr int RING_OFF = 0, RING_BYTES = 131072;
constexpr int LDSCTL_OFF = RING_BYTES, MISC_OFF = LDSCTL_OFF + 320;
constexpr int LDS_BYTES = 147456;

struct Frame {
    LAS unsigned char* lds;
    volatile LAS unsigned* MISC;
    gu32* ctl;
    int tid, lane, wave;
    int vcu, G;
    const float *x, *c, *w_ada, *b_ada, *g_pre, *g_post, *w_in, *sinks, *ln_g, *ln_b, *w_s, *b_s, *w_pa, *w_pb, *w_out;
    const int* pos;
    float* out;
    bf16 *WinT, *WpT, *WoT, *WsB, *H, *QKV, *ZA, *UZ, *VG, *GT, *MRG;
    float *ADA, *COS, *SIN, *RSS;
};

__device__ __forceinline__ float wave_sum(float v) {
#pragma unroll
    for (int o = 1; o < 64; o <<= 1) v += __shfl_xor(v, o);
    return v;
}
__device__ __forceinline__ float bfl(unsigned w) { return __uint_as_float(w << 16); }
__device__ __forceinline__ float bfh(unsigned w) { return __uint_as_float(w & 0xffff0000u); }
__device__ __forceinline__ float sigmf(float v) { return __builtin_amdgcn_rcpf(1.0f + __builtin_amdgcn_exp2f(-1.4426950408889634f * v)); }

__device__ __forceinline__ int proj_logical_col(int np) {
    const int pn = np >> 8, p = np & 255, bj = p >> 7, w = (p >> 5) & 3, dd = p & 31;
    if (pn < 2) return (4 * pn + w) * 64 + bj * 32 + dd;
    if (pn == 2) return w < 2 ? 512 + w * 64 + bj * 32 + dd : 640 + bj * 64 + (w - 2) * 32 + dd;
    if (pn < 5) return 768 + (pn - 3) * 256 + p;
    if (pn < 9) return (bj == 0 ? 1280 : 2304) + (pn - 5) * 128 + (p & 127);
    if (pn < 11) return 1792 + (pn - 9) * 256 + p;
    return 2816 + (pn - 11) * 256 + p;
}

__device__ __forceinline__ void p0_transpose_item(const float* W, int Nsrc, int k0, int csrc, bf16* WT, int ldk, int ndst, int kdst, LAS float* scr, int lane) {
#pragma unroll 8
    for (int i = 0; i < 32; ++i) { const int kk = 2 * i + (lane >> 5); scr[kk * 33 + (lane & 31)] = W[(size_t)(k0 + kk) * Nsrc + csrc + (lane & 31)]; }
    LDS_WAIT(); asm volatile("" ::: "memory");
    const int c = lane & 7;
#pragma unroll
    for (int j = 0; j < 4; ++j) { const int n = (lane >> 3) + 8 * j; const LAS float* s = scr + (8 * c) * 33 + n;
        v4u o; o.x = pk2(s[0 * 33], s[1 * 33]); o.y = pk2(s[2 * 33], s[3 * 33]); o.z = pk2(s[4 * 33], s[5 * 33]); o.w = pk2(s[6 * 33], s[7 * 33]);
        *(GAS v4u*)(WT + (size_t)(ndst + n) * ldk + kdst + 8 * c) = o; }
    LDS_WAIT(); asm volatile("" ::: "memory");
}

__device__ __forceinline__ void sincos_acc(float a, float& s, float& c) {
    const double x = (double)a;
    const double kd = rint(x * 0.63661977236758134);
    double r = fma(-kd, 1.5707963267948966, x); r = fma(-kd, 6.123233995736766e-17, r);
    const int q = ((int)kd) & 3;
    const double r2 = r * r;
    const double sp = r * (1.0 + r2 * (-1.0 / 6.0 + r2 * (1.0 / 120.0 + r2 * (-1.0 / 5040.0 + r2 * (1.0 / 362880.0 + r2 * (-1.0 / 39916800.0))))));
    const double cp = 1.0 + r2 * (-0.5 + r2 * (1.0 / 24.0 + r2 * (-1.0 / 720.0 + r2 * (1.0 / 40320.0 + r2 * (-1.0 / 3628800.0 + r2 * (1.0 / 479001600.0))))));
    const double ss = (q & 1) ? cp : sp, cc = (q & 1) ? sp : cp;
    s = (float)((q & 2) ? -ss : ss);
    c = (float)(((q + 1) & 2) ? -cc : cc);
}

__device__ __forceinline__ void p0_prologue(Frame& F, const float* invf  ) {
    const int gw = F.vcu * NWAVES + F.wave, NGW = F.G * NWAVES;
    {
        LAS float* cs = (LAS float*)(F.lds);
        LAS float* red = (LAS float*)(F.lds + 32768);
        for (int i = F.tid; i < BATCH * DM; i += NWAVES * 64) { const float v = F.c[i]; cs[i] = v * sigmf(v); }
        __syncthreads();
        for (int cb = F.vcu; cb < 256; cb += F.G) {
            const int j = F.tid % 12, kg = F.tid / 12;
            float a[BATCH];
#pragma unroll
            for (int b = 0; b < BATCH; ++b) a[b] = 0.f;
            if (kg < 42) for (int k = kg; k < DM; k += 42) { const float w = F.w_ada[(size_t)k * 3072 + cb * 12 + j];
#pragma unroll
                for (int b = 0; b < BATCH; ++b) a[b] += cs[b * DM + k] * w; }
            if (kg < 42) {
#pragma unroll
                for (int b = 0; b < BATCH; ++b) red[(kg * 12 + j) * 8 + b] = a[b]; }
            __syncthreads();
            if (F.tid < 96) { const int jj = F.tid >> 3, b = F.tid & 7; float s = 0.f;
                for (int g = 0; g < 42; ++g) s += red[(g * 12 + jj) * 8 + b];
                F.ADA[b * 3072 + cb * 12 + jj] = s + F.b_ada[cb * 12 + jj]; }
            __syncthreads();
        }
    }
    {
        LAS float* scr = (LAS float*)(F.lds + RING_OFF + F.wave * 16384);
        constexpr int I_IN = 16 * (D_IN / 32), I_P = 8 * 32, I_O = 16 * 32;
        constexpr int NITEMS = I_IN + 2 * I_P + I_O;
        for (int it = gw; it < NITEMS; it += NGW) {
            int r = it;
            if (r < I_IN) { const int nb = r % (D_IN / 32), kb = r / (D_IN / 32); p0_transpose_item(F.w_in, D_IN, 64 * kb, proj_logical_col(32 * nb), F.WinT, 1024, 32 * nb, 64 * kb, scr, F.lane); continue; } r -= I_IN;
            if (r < I_P) { const int nb = r % 32, kb = r / 32; p0_transpose_item(F.w_pa, 1024, 64 * kb, 32 * nb, F.WpT, 1024, 32 * nb, 64 * kb, scr, F.lane); continue; } r -= I_P;
            if (r < I_P) { const int nb = r % 32, kb = r / 32; p0_transpose_item(F.w_pb, 1024, 64 * kb, 32 * nb, F.WpT, 1024, 32 * nb, 512 + 64 * kb, scr, F.lane); continue; } r -= I_P;
            { const int nb = r % 32, kb = r / 32; p0_transpose_item(F.w_out, 1024, 64 * kb, 32 * nb, F.WoT, 1024, 32 * nb, 64 * kb, scr, F.lane); }
        }
    }
    const int gt = F.vcu * (NWAVES * 64) + F.tid, NGT = F.G * NWAVES * 64;
    for (int i = gt; i < 4 * 128 * 128; i += NGT) { const int s = i & 127, t = (i >> 7) & 127; F.WsB[i] = (bf16)(s <= t ? f2bf(F.w_s[i]) : 0u); }
    for (int i = gt; i < M * 32; i += NGT) { const int tok = i >> 5, fi = i & 31; const float ang = (float)F.pos[tok] * invf[fi]; float s, c; sincos_acc(ang, s, c); F.COS[i] = c; F.SIN[i] = s; }
}

__device__ __forceinline__ void p1_prenorm(Frame& F) {
    const int gw = F.vcu * NWAVES + F.wave, NGW = F.G * NWAVES;
    for (int m = gw; m < M; m += NGW) {
        const int b = m / SEQ;
        const GAS f32x4* xr = (const GAS f32x4*)(F.x + (size_t)m * DM) + F.lane;
        f32x4 v[4]; float s2 = 0.f;
#pragma unroll
        for (int j = 0; j < 4; ++j) { v[j] = xr[64 * j]; s2 += (v[j].x * v[j].x + v[j].y * v[j].y) + (v[j].z * v[j].z + v[j].w * v[j].w); }
        const float rstd = 1.f / sqrtf(wave_sum(s2) * (1.f / DM) + EPS);
        GAS unsigned long long* o8 = (GAS unsigned long long*)(F.H + (size_t)m * DM) + F.lane;
#pragma unroll
        for (int j = 0; j < 4; ++j) { const int col = 4 * F.lane + 256 * j;
            const f32x4 g = *(const f32x4*)(F.g_pre + col), sh = *(const f32x4*)(F.ADA + b * 3072 + col), sc = *(const f32x4*)(F.ADA + b * 3072 + 1024 + col);
            const f32x4 h = v[j] * rstd * g * (sc + 1.0f) + sh;
            o8[64 * j] = (unsigned long long)pk2(h.x, h.y) | ((unsigned long long)pk2(h.z, h.w) << 32); }
    }
}

__device__ __forceinline__ void p6_postnorm(Frame& F) {
    const int gw = F.vcu * NWAVES + F.wave, NGW = F.G * NWAVES;
    for (int m = gw; m < M; m += NGW) {
        const int b = m / SEQ;
        const float part = F.lane < 16 ? F.RSS[(size_t)m * 16 + F.lane] : 0.f;
        const float rstd = 1.f / sqrtf(wave_sum(part) * (1.f / DM) + EPS);
        const GAS f32x4* xr = (const GAS f32x4*)(F.x + (size_t)m * DM) + F.lane;
        const GAS unsigned long long* yr = (const GAS unsigned long long*)(F.H + (size_t)m * DM) + F.lane;
        GAS f32x4* orow = (GAS f32x4*)(F.out + (size_t)m * DM) + F.lane;
#pragma unroll
        for (int j = 0; j < 4; ++j) { const int col = 4 * F.lane + 256 * j;
            const f32x4 xv = xr[64 * j]; const unsigned long long yw = yr[64 * j];
            const f32x4 g = *(const f32x4*)(F.g_post + col), gt = *(const f32x4*)(F.ADA + b * 3072 + 2048 + col);
            const f32x4 y = (f32x4){bfl((unsigned)yw), bfh((unsigned)yw), bfl((unsigned)(yw >> 32)), bfh((unsigned)(yw >> 32))};
            orow[64 * j] = xv + gt * (y * rstd * g); }
    }
}

typedef float f32x16 __attribute__((ext_vector_type(16)));
typedef unsigned u32x2 __attribute__((ext_vector_type(2)));
typedef float f32x2_t __attribute__((ext_vector_type(2))); typedef __bf16 bf16x2_t __attribute__((ext_vector_type(2)));
__device__ __forceinline__ unsigned cvtpk(float lo, float hi) { f32x2_t v = {lo, hi}; bf16x2_t b = __builtin_convertvector(v, bf16x2_t); return __builtin_bit_cast(unsigned, b); }
constexpr int KS_PITCH = 144, VT_PITCH = 520, KS_BYTES = 256 * KS_PITCH, VT_OFF = KS_BYTES;
constexpr int VN_PITCH = 272, VN_BYTES = 128 * VN_PITCH, ST_OFF = 2 * VN_BYTES;

__device__ __forceinline__ void attn_block(Frame& F, int blk) {
    const int nb = blk & 31, base = blk * 128, lane = F.lane, q = lane & 31, h = lane >> 5;
    LAS unsigned char* Ks = F.lds; LAS unsigned char* Vt = F.lds + VT_OFF;
    for (int kvh = 0; kvh < 2; ++kvh) {
#pragma unroll
        for (int i = 0; i < 4; ++i) { const int id = F.tid + 512 * i, key = id >> 3, ch = id & 7; const bool ok = (nb > 0) || (key >= 128);
            const size_t row = (size_t)(base - 128 + key);
            v4u kv = (v4u){0u, 0u, 0u, 0u}, vv = (v4u){0u, 0u, 0u, 0u};
            if (ok) { kv = *(const GAS v4u*)(F.QKV + row * 768 + 512 + kvh * 64 + ch * 8); vv = *(const GAS v4u*)(F.QKV + row * 768 + 640 + kvh * 64 + ch * 8); }
            *(LAS v4u*)(Ks + key * KS_PITCH + ch * 16) = kv;
            LAS unsigned short* vp = (LAS unsigned short*)(Vt + (ch * 8) * VT_PITCH + key * 2);
            vp[0 * (VT_PITCH / 2)] = (unsigned short)(vv.x & 0xffffu); vp[1 * (VT_PITCH / 2)] = (unsigned short)(vv.x >> 16);
            vp[2 * (VT_PITCH / 2)] = (unsigned short)(vv.y & 0xffffu); vp[3 * (VT_PITCH / 2)] = (unsigned short)(vv.y >> 16);
            vp[4 * (VT_PITCH / 2)] = (unsigned short)(vv.z & 0xffffu); vp[5 * (VT_PITCH / 2)] = (unsigned short)(vv.z >> 16);
            vp[6 * (VT_PITCH / 2)] = (unsigned short)(vv.w & 0xffffu); vp[7 * (VT_PITCH / 2)] = (unsigned short)(vv.w >> 16); }
        __syncthreads();
        const int g = F.wave >> 1, hq = kvh * 4 + g;
        const float sink2 = F.sinks[hq] * 1.4426950408889634f;
#pragma unroll 1
        for (int t = 0; t < 2; ++t) {
            const int qi = 2 * (F.wave & 1) + t; const size_t row = (size_t)(base + 32 * qi + q);
            bf16x8 qf[4];
#pragma unroll
            for (int ks = 0; ks < 4; ++ks) qf[ks] = *(const GAS bf16x8*)(F.QKV + row * 768 + hq * 64 + 16 * ks + 8 * h);
            f32x16 S[5];
#pragma unroll
            for (int kt = 0; kt < 5; ++kt) {
                f32x16 a = (f32x16){0.f, 0.f, 0.f, 0.f, 0.f, 0.f, 0.f, 0.f, 0.f, 0.f, 0.f, 0.f, 0.f, 0.f, 0.f, 0.f};
#pragma unroll
                for (int ks = 0; ks < 4; ++ks) { const bf16x8 kf = *(const LAS bf16x8*)(Ks + (32 * (qi + kt) + q) * KS_PITCH + (16 * ks + 8 * h) * 2);
                    a = __builtin_amdgcn_mfma_f32_32x32x16_bf16(kf, qf[ks], a, 0, 0, 0); }
                S[kt] = a; }
            float mx = sink2;
#pragma unroll
            for (int kt = 0; kt < 5; ++kt) { const bool tile_ok = (nb > 0) || (qi + kt >= 4);
#pragma unroll
                for (int r = 0; r < 16; ++r) { const int krow = (r & 3) + 8 * (r >> 2) + 4 * h; const int jrel = 32 * kt + krow - q;
                    const bool ok = tile_ok && (jrel > 0) && (jrel <= 128);
                    S[kt][r] = ok ? S[kt][r] : -INFINITY; mx = fmaxf(mx, S[kt][r]); } }
            mx = fmaxf(mx, __shfl_xor(mx, 32));
            float ls = 0.f;
#pragma unroll
            for (int kt = 0; kt < 5; ++kt)
#pragma unroll
                for (int r = 0; r < 16; ++r) { const float p = __builtin_amdgcn_exp2f(S[kt][r] - mx); S[kt][r] = p; ls += p; }
            ls += __shfl_xor(ls, 32);
            const float rl = 1.0f / (ls + __builtin_amdgcn_exp2f(sink2 - mx));
            f32x16 O[2];
#pragma unroll
            for (int dt = 0; dt < 2; ++dt) O[dt] = (f32x16){0.f, 0.f, 0.f, 0.f, 0.f, 0.f, 0.f, 0.f, 0.f, 0.f, 0.f, 0.f, 0.f, 0.f, 0.f, 0.f};
#pragma unroll
            for (int kt = 0; kt < 5; ++kt)
#pragma unroll
                for (int s = 0; s < 2; ++s) {
                    v4u pw; pw.x = cvtpk(S[kt][8 * s + 0], S[kt][8 * s + 1]); pw.y = cvtpk(S[kt][8 * s + 2], S[kt][8 * s + 3]); pw.z = cvtpk(S[kt][8 * s + 4], S[kt][8 * s + 5]); pw.w = cvtpk(S[kt][8 * s + 6], S[kt][8 * s + 7]);
                    const bf16x8 pf = __builtin_bit_cast(bf16x8, pw);
#pragma unroll
                    for (int dt = 0; dt < 2; ++dt) { const LAS unsigned char* vp = Vt + (32 * dt + q) * VT_PITCH + (32 * (qi + kt) + 16 * s + 4 * h) * 2;
                        const u32x2 lo = *(const LAS u32x2*)vp, hi = *(const LAS u32x2*)(vp + 16);
                        const v4u vw = (v4u){lo.x, lo.y, hi.x, hi.y};
                        O[dt] = __builtin_amdgcn_mfma_f32_32x32x16_bf16(__builtin_bit_cast(bf16x8, vw), pf, O[dt], 0, 0, 0); } }
#pragma unroll
            for (int dt = 0; dt < 2; ++dt)
#pragma unroll
                for (int r4 = 0; r4 < 4; ++r4) { const int d0 = 32 * dt + 8 * r4 + 4 * h;
                    const u32x2 zw = *(const GAS u32x2*)(F.ZA + row * 512 + hq * 64 + d0);
                    u32x2 ow; ow.x = cvtpk(O[dt][4 * r4 + 0] * rl * bfl(zw.x), O[dt][4 * r4 + 1] * rl * bfh(zw.x)); ow.y = cvtpk(O[dt][4 * r4 + 2] * rl * bfl(zw.y), O[dt][4 * r4 + 3] * rl * bfh(zw.y));
                    *(GAS u32x2*)(F.H + row * 1024 + hq * 64 + d0) = ow; }
        }
        __syncthreads();
    }
}

__device__ __forceinline__ void gmlp_block(Frame& F, int blk) {
    const int base = blk * 128, lane = F.lane;
    LAS float* ST = (LAS float*)(F.lds + ST_OFF);
#pragma unroll 4
    for (int i = 0; i < 16; ++i) { const int tk = 16 * F.wave + i;
        const v4u w = *(const GAS v4u*)(F.VG + (size_t)(base + tk) * 512 + 8 * lane);
        const float v0 = bfl(w.x), v1 = bfh(w.x), v2 = bfl(w.y), v3 = bfh(w.y), v4 = bfl(w.z), v5 = bfh(w.z), v6 = bfl(w.w), v7 = bfh(w.w);
        const float mean = wave_sum(((v0 + v1) + (v2 + v3)) + ((v4 + v5) + (v6 + v7))) * (1.f / 512.f);
        const float d0 = v0 - mean, d1 = v1 - mean, d2 = v2 - mean, d3 = v3 - mean, d4 = v4 - mean, d5 = v5 - mean, d6 = v6 - mean, d7 = v7 - mean;
        const float var = wave_sum(((d0 * d0 + d1 * d1) + (d2 * d2 + d3 * d3)) + ((d4 * d4 + d5 * d5) + (d6 * d6 + d7 * d7))) * (1.f / 512.f);
        if (lane == 0) { ST[2 * tk] = mean; ST[2 * tk + 1] = 1.f / sqrtf(var + EPS); } }
    __syncthreads();
#pragma unroll 1
    for (int gp = 0; gp < 2; ++gp) {
        { const int g2 = F.tid >> 8, co = (F.tid >> 4) & 15, so = F.tid & 15, ch0 = (2 * gp + g2) * 128 + 8 * co;
            const f32x4 ga = *(const f32x4*)(F.ln_g + ch0), gb = *(const f32x4*)(F.ln_g + ch0 + 4), ba = *(const f32x4*)(F.ln_b + ch0), bb = *(const f32x4*)(F.ln_b + ch0 + 4);
            float vn[8][8];
#pragma unroll
            for (int i = 0; i < 8; ++i) { const int tk = 8 * so + i; const v4u w = *(const GAS v4u*)(F.VG + (size_t)(base + tk) * 512 + ch0);
                const float mean = ST[2 * tk], rstd = ST[2 * tk + 1];
                vn[i][0] = (bfl(w.x) - mean) * rstd * ga[0] + ba[0]; vn[i][1] = (bfh(w.x) - mean) * rstd * ga[1] + ba[1]; vn[i][2] = (bfl(w.y) - mean) * rstd * ga[2] + ba[2]; vn[i][3] = (bfh(w.y) - mean) * rstd * ga[3] + ba[3];
                vn[i][4] = (bfl(w.z) - mean) * rstd * gb[0] + bb[0]; vn[i][5] = (bfh(w.z) - mean) * rstd * gb[1] + bb[1]; vn[i][6] = (bfl(w.w) - mean) * rstd * gb[2] + bb[2]; vn[i][7] = (bfh(w.w) - mean) * rstd * gb[3] + bb[3]; }
            LAS unsigned char* dst = F.lds + g2 * VN_BYTES + (8 * co) * VN_PITCH + so * 16;
#pragma unroll
            for (int cc = 0; cc < 8; ++cc) { v4u o; o.x = cvtpk(vn[0][cc], vn[1][cc]); o.y = cvtpk(vn[2][cc], vn[3][cc]); o.z = cvtpk(vn[4][cc], vn[5][cc]); o.w = cvtpk(vn[6][cc], vn[7][cc]);
                *(LAS v4u*)(dst + cc * VN_PITCH) = o; } }
        __syncthreads();
        { const int g2 = F.wave >> 2, cj = F.wave & 3, g = 2 * gp + g2, t = lane & 31, h = lane >> 5;
            f32x16 acc[4];
#pragma unroll
            for (int ti = 0; ti < 4; ++ti) acc[ti] = (f32x16){0.f, 0.f, 0.f, 0.f, 0.f, 0.f, 0.f, 0.f, 0.f, 0.f, 0.f, 0.f, 0.f, 0.f, 0.f, 0.f};
            const LAS unsigned char* ap = F.lds + g2 * VN_BYTES + (32 * cj + t) * VN_PITCH + 16 * h;
            const bf16* wp = F.WsB + (size_t)g * 16384 + (size_t)t * 128 + 8 * h;
#pragma unroll
            for (int ks = 0; ks < 8; ++ks) { const bf16x8 af = *(const LAS bf16x8*)(ap + 32 * ks);
#pragma unroll
                for (int ti = 0; ti < 4; ++ti) if (2 * (ti + 1) > ks) { const bf16x8 bfr = *(const GAS bf16x8*)(wp + (size_t)ti * 4096 + 16 * ks);
                    acc[ti] = __builtin_amdgcn_mfma_f32_32x32x16_bf16(af, bfr, acc[ti], 0, 0, 0); } }
#pragma unroll
            for (int ti = 0; ti < 4; ++ti) { const int tk = 32 * ti + t; const float bs = F.b_s[g * 128 + tk]; const size_t row = (size_t)(base + tk);
#pragma unroll
                for (int r4 = 0; r4 < 4; ++r4) { const int c0 = g * 128 + 32 * cj + 8 * r4 + 4 * h;
                    const u32x2 uw = *(const GAS u32x2*)(F.UZ + row * 512 + c0);
                    u32x2 ow; ow.x = cvtpk((acc[ti][4 * r4 + 0] + bs) * bfl(uw.x), (acc[ti][4 * r4 + 1] + bs) * bfh(uw.x)); ow.y = cvtpk((acc[ti][4 * r4 + 2] + bs) * bfl(uw.y), (acc[ti][4 * r4 + 3] + bs) * bfh(uw.y));
                    *(GAS u32x2*)(F.H + row * 1024 + 512 + c0) = ow; } } }
        __syncthreads();
    }
}

__device__ __forceinline__ void naive_mixers(Frame& F, int blk) {
    const int nb = blk & 31, base = blk * 128, lane = F.lane;
    for (int it = F.wave; it < 128 * 8; it += NWAVES) { const int i = it >> 3, hq = it & 7, kvh = hq >> 2; const size_t row = (size_t)(base + i);
        const float qd = bfl((unsigned)F.QKV[row * 768 + hq * 64 + lane]);
        const float sink2 = F.sinks[hq] * 1.4426950408889634f;
        float m = sink2, l = 1.0f, o = 0.f;
        int j0 = i - 127; if (nb == 0 && j0 < 0) j0 = 0;
        for (int j = j0; j <= i; ++j) { const size_t kr = (size_t)(base + j);
            const float s = wave_sum(qd * bfl((unsigned)F.QKV[kr * 768 + 512 + kvh * 64 + lane]));
            const float mn = fmaxf(m, s), sc = exp2f(m - mn), p = exp2f(s - mn);
            l = l * sc + p; o = o * sc + p * bfl((unsigned)F.QKV[kr * 768 + 640 + kvh * 64 + lane]); m = mn; }
        const float y = o / l * bfl((unsigned)F.ZA[row * 512 + hq * 64 + lane]);
        F.H[row * 1024 + hq * 64 + lane] = (bf16)f2bf(y); }
    LAS float* ST = (LAS float*)(F.lds);
    __syncthreads();
    if (F.tid < 128) { const size_t row = (size_t)(base + F.tid); float s = 0.f; for (int c = 0; c < 512; ++c) s += bfl((unsigned)F.VG[row * 512 + c]);
        const float mean = s / 512.f; float q = 0.f; for (int c = 0; c < 512; ++c) { const float dlt = bfl((unsigned)F.VG[row * 512 + c]) - mean; q += dlt * dlt; }
        ST[2 * F.tid] = mean; ST[2 * F.tid + 1] = 1.f / sqrtf(q / 512.f + EPS); }
    __syncthreads();
    for (int it = F.tid; it < 128 * 512; it += NWAVES * 64) { const int t = it >> 9, ch = it & 511, g = ch >> 7; float acc = 0.f;
        for (int s = 0; s <= t; ++s) { const float vn = (bfl((unsigned)F.VG[(size_t)(base + s) * 512 + ch]) - ST[2 * s]) * ST[2 * s + 1] * F.ln_g[ch] + F.ln_b[ch];
            acc += F.w_s[(g * 128 + t) * 128 + s] * vn; }
        const float y = (acc + F.b_s[g * 128 + t]) * bfl((unsigned)F.UZ[(size_t)(base + t) * 512 + ch]);
        F.H[(size_t)(base + t) * 1024 + 512 + ch] = (bf16)f2bf(y); }
    __syncthreads();
}

__device__ __forceinline__ float naive_dot_in(Frame& F, size_t row, int c) { float a = 0.f; for (int k = 0; k < DM; ++k) a += bfl((unsigned)F.H[row * 1024 + k]) * F.w_in[(size_t)k * D_IN + c]; return a; }
__device__ __forceinline__ float gelu_exact(float v) { return 0.5f * v * (1.0f + erff(v * 0.70710678118654752f)); }
__device__ __forceinline__ void naive_proj(Frame& F) {
    const size_t gt = (size_t)F.vcu * (NWAVES * 64) + F.tid, NGT = (size_t)F.G * NWAVES * 64;
    for (size_t it = gt; it < (size_t)M * 4352; it += NGT) { const size_t row = it / 4352; const int j = (int)(it % 4352);
        if (j < 640) { const int d = j & 63, dd = d & 31; const int c1 = (j & ~63) + dd, c2 = c1 + 32;
            const float t1 = naive_dot_in(F, row, c1), t2 = naive_dot_in(F, row, c2), cs = F.COS[row * 32 + dd], sn = F.SIN[row * 32 + dd];
            float o = d < 32 ? t1 * cs - t2 * sn : t2 * cs + t1 * sn; if (j < 512) o *= 0.125f * 1.4426950408889634f;
            F.QKV[row * 768 + j] = (bf16)f2bf(o); }
        else if (j < 768) F.QKV[row * 768 + j] = (bf16)f2bf(naive_dot_in(F, row, j));
        else if (j < 1280) { const float v = naive_dot_in(F, row, j); F.ZA[row * 512 + (j - 768)] = (bf16)f2bf(v * sigmf(v)); }
        else if (j < 1792) { const float u = naive_dot_in(F, row, j), z = naive_dot_in(F, row, j + 1024); F.UZ[row * 512 + (j - 1280)] = (bf16)f2bf(gelu_exact(u) * z * sigmf(z)); }
        else if (j < 2304) { const float v = naive_dot_in(F, row, j); F.VG[row * 512 + (j - 1792)] = (bf16)f2bf(gelu_exact(v)); }
        else { const float v = naive_dot_in(F, row, j + 512); F.GT[row * 2048 + (j - 2304)] = (bf16)f2bf(sigmf(v)); } }
}
__device__ __forceinline__ void naive_merge(Frame& F) {
    const size_t gt = (size_t)F.vcu * (NWAVES * 64) + F.tid, NGT = (size_t)F.G * NWAVES * 64;
    for (size_t it = gt; it < (size_t)M * DM; it += NGT) { const size_t row = it >> 10; const int n = (int)(it & 1023); float a = 0.f, b = 0.f;
        for (int k = 0; k < 512; ++k) { a += bfl((unsigned)F.H[row * 1024 + k]) * F.w_pa[(size_t)k * 1024 + n]; b += bfl((unsigned)F.H[row * 1024 + 512 + k]) * F.w_pb[(size_t)k * 1024 + n]; }
        F.MRG[it] = (bf16)f2bf(bfl((unsigned)F.GT[row * 2048 + n]) * a + bfl((unsigned)F.GT[row * 2048 + 1024 + n]) * b); }
}
__device__ __forceinline__ void naive_out(Frame& F) {
    LAS float* red = (LAS float*)F.lds;
    for (int row = F.vcu; row < M; row += F.G) { float q = 0.f;
        for (int n = F.tid; n < DM; n += NWAVES * 64) { float a = 0.f; for (int k = 0; k < DM; ++k) a += bfl((unsigned)F.MRG[(size_t)row * 1024 + k]) * F.w_out[(size_t)k * 1024 + n];
            F.H[(size_t)row * 1024 + n] = (bf16)f2bf(a); q += a * a; }
        q = wave_sum(q); if (F.lane == 0) red[F.wave] = q; __syncthreads();
        if (F.tid < 16) F.RSS[(size_t)row * 16 + F.tid] = F.tid == 0 ? ((red[0] + red[1]) + (red[2] + red[3])) + ((red[4] + red[5]) + (red[6] + red[7])) : 0.f;
        __syncthreads(); }
}

struct Args { const void* in[16]; float* out; unsigned char* ws; float invf[32]; int ph_lo, ph_hi, li, pad; };

typedef const __attribute__((address_space(4))) Args* KArgs;
__device__ __forceinline__ void fresh_tid(Frame& F) { int t = threadIdx.x; asm volatile("" : "+v"(t)); F.tid = t; F.lane = t & 63; }
__device__ __forceinline__ KArgs fresh_args() { KArgs p = (KArgs)__builtin_amdgcn_kernarg_segment_ptr(); asm volatile("" : "+s"(p)); return p; }
__device__ __forceinline__ void fill_frame(Frame& F, KArgs a) {
    unsigned char* ws = a->ws;
    F.x = (const float*)a->in[0]; F.c = (const float*)a->in[1]; F.pos = (const int*)a->in[2]; F.w_ada = (const float*)a->in[3]; F.b_ada = (const float*)a->in[4];
    F.g_pre = (const float*)a->in[5]; F.g_post = (const float*)a->in[6]; F.w_in = (const float*)a->in[7]; F.sinks = (const float*)a->in[8];
    F.ln_g = (const float*)a->in[9]; F.ln_b = (const float*)a->in[10]; F.w_s = (const float*)a->in[11]; F.b_s = (const float*)a->in[12];
    F.w_pa = (const float*)a->in[13]; F.w_pb = (const float*)a->in[14]; F.w_out = (const float*)a->in[15]; F.out = a->out;
    F.WinT = (bf16*)(ws + WS_WIN); F.WpT = (bf16*)(ws + WS_WP); F.WoT = (bf16*)(ws + WS_WO); F.WsB = (bf16*)(ws + WS_WS);
    F.H = (bf16*)(ws + WS_H); F.QKV = (bf16*)(ws + WS_QKV); F.ZA = (bf16*)(ws + WS_ZA); F.UZ = (bf16*)(ws + WS_UZ); F.VG = (bf16*)(ws + WS_VG); F.GT = (bf16*)(ws + WS_G); F.MRG = (bf16*)(ws + WS_MRG);
    F.ADA = (float*)(ws + WS_ADA); F.COS = (float*)(ws + WS_COS); F.SIN = (float*)(ws + WS_SIN); F.RSS = (float*)(ws + WS_RSS);
}

#ifndef DBG_STOP
#define DBG_STOP -1
#endif
__device__ __forceinline__ float bf2f(bf16 v) { return __uint_as_float((unsigned)v << 16); }
__device__ __forceinline__ void dbg_dump(Frame& F) {
    const size_t gt = (size_t)F.vcu * (NWAVES * 64) + F.tid, NGT = (size_t)F.G * NWAVES * 64, NOUT = (size_t)M * DM;
    for (size_t i = gt; i < NOUT; i += NGT) {
        float v = 0.f;
        if (DBG_STOP == 0) v = bf2f(F.WinT[i % ((size_t)D_IN * 1024)]) + bf2f(F.WpT[i % (1024 * 1024)]) + bf2f(F.WoT[i % (1024 * 1024)]) + bf2f(F.WsB[i % 65536]) + F.ADA[i % 24576] + F.COS[i % ((size_t)M * 32)] + F.SIN[i % ((size_t)M * 32)];
        if (DBG_STOP == 1 || DBG_STOP == 3) v = bf2f(F.H[i]);
        if (DBG_STOP == 2) v = bf2f(F.GT[2 * i]) + 2.f * bf2f(F.GT[2 * i + 1]) + bf2f(F.QKV[i % ((size_t)M * 768)]) + bf2f(F.ZA[i % ((size_t)M * 512)]) + bf2f(F.UZ[i % ((size_t)M * 512)]) + bf2f(F.VG[i % ((size_t)M * 512)]);
        if (DBG_STOP == 4) v = bf2f(F.MRG[i]);
        if (DBG_STOP == 5) v = bf2f(F.H[i]) + F.RSS[i % ((size_t)M * 16)];
        F.out[i] = v;
    }
}
__global__ void __launch_bounds__(NWAVES * 64, 2) hybrid_fwd(Args args) {
    extern __shared__ __attribute__((aligned(16))) unsigned char lds[];
    Frame F;
    F.lds = (LAS unsigned char*)lds;
    F.MISC = (volatile LAS unsigned*)(F.lds + MISC_OFF);
    F.tid = threadIdx.x; F.lane = F.tid & 63; F.wave = __builtin_amdgcn_readfirstlane(F.tid >> 6);
    F.G = gridDim.x; { const int bx = blockIdx.x; F.vcu = (F.G % 8 == 0) ? (bx % 8) * (F.G / 8) + bx / 8 : bx; }
    F.ctl = (gu32*)(args.ws + WS_CTL);
    for (int u = F.tid; u < (LDS_BYTES - LDSCTL_OFF) / 4; u += NWAVES * 64) ((LAS unsigned*)(F.lds + LDSCTL_OFF))[u] = 0u;
    __syncthreads();
    if (F.tid < 32) ((LAS float*)(F.lds + LDSCTL_OFF + 1024))[F.tid] = args.invf[F.tid];
    __syncthreads();
    XcdBarrier bar; bar.bar = (unsigned*)(F.ctl + CW_BAR); bar.x = 0; bar.st = nullptr;
    if (N_LAUNCHES != PER_PHASE) bar = xcd_barrier_post((unsigned*)(F.ctl + CW_BAR), F.MISC + 8);
#define GRID_BAR() do { if (N_LAUNCHES != PER_PHASE) xcd_barrier(bar); } while (0)
    const int lo = args.ph_lo, hi = args.ph_hi;
#define IN(k) (lo <= (k) && (k) < hi)
#define BOTH(k) (IN(k) && IN((k) + 1))
    if (IN(0)) { fill_frame(F, fresh_args()); fresh_tid(F); p0_prologue(F, (const float*)(lds + LDSCTL_OFF + 1024)); if (BOTH(0)) GRID_BAR(); }
    if (IN(1)) { fill_frame(F, fresh_args()); fresh_tid(F); p1_prenorm(F); if (BOTH(1)) GRID_BAR(); }
    if (IN(2)) { fill_frame(F, fresh_args()); fresh_tid(F);
#if defined(NAIVE_P2)
        naive_proj(F);
#endif
#if defined(DBG_TILEMASK)
        GRID_BAR();
#endif
#if !defined(NAIVE_P2) || defined(DBG_TILEMASK)
        pg8::Gemm g{F.H, F.WinT, M, D_IN, DM}; pg8::StaticOrder S; S.init(M, D_IN, F.G, (int)blockIdx.x);
        pg8::EpiProj E{F.QKV, F.ZA, F.UZ, F.VG, F.GT, F.COS, F.SIN};
        pg8::gemm_phase<pg8::EpiProj, pg8::StaticOrder, false, false>(F.lds + RING_OFF, g, S, E);
#endif
        if (BOTH(2)) GRID_BAR();
    }
    if (IN(3)) { fill_frame(F, fresh_args()); fresh_tid(F);
#if defined(NAIVE_P3)
        for (int blk = F.vcu; blk < NBLK; blk += F.G) naive_mixers(F, blk);
#else
        for (int blk = F.vcu; blk < NBLK; blk += F.G) { attn_block(F, blk); gmlp_block(F, blk); }
#endif
        if (BOTH(3)) GRID_BAR();
    }
    if (IN(4)) { fill_frame(F, fresh_args()); fresh_tid(F);
#if defined(NAIVE_P45)
        naive_merge(F);
#else
        pg8::Gemm g{F.H, F.WpT, M, DM, DM}; pg8::StaticOrder S; S.init(M, DM, F.G, (int)blockIdx.x);
        pg8::EpiMerge E{F.GT, F.MRG};
        pg8::gemm_phase<pg8::EpiMerge, pg8::StaticOrder, false, false>(F.lds + RING_OFF, g, S, E);
#endif
        if (BOTH(4)) GRID_BAR();
    }
    if (IN(5)) { fill_frame(F, fresh_args()); fresh_tid(F);
#if defined(NAIVE_P45)
        naive_out(F);
#else
        pg8::Gemm g{F.MRG, F.WoT, M, DM, DM}; pg8::StaticOrder S; S.init(M, DM, F.G, (int)blockIdx.x);
        pg8::EpiY E{F.H, F.RSS};
        pg8::gemm_phase<pg8::EpiY, pg8::StaticOrder, false, false>(F.lds + RING_OFF, g, S, E);
#endif
        if (BOTH(5)) GRID_BAR();
    }
    if (IN(6)) { fill_frame(F, fresh_args()); fresh_tid(F); if (DBG_STOP >= 0) dbg_dump(F); else p6_postnorm(F); }
#undef IN
#undef BOTH
}

extern "C" void kernel_launch(void* const* d_in, const int* in_sizes, int n_in, void* d_out, int out_size, void* d_ws, size_t ws_size, hipStream_t stream) {
    static int grid = 0;
    if (grid == 0) {
        if (n_in != 16 || in_sizes[0] != M * DM || out_size != M * DM || ws_size < WS_END) { fprintf(stderr, "kernel_launch: unexpected shapes (n_in %d, in0 %d, out %d, ws %zu); nothing launched\n", n_in, n_in > 0 ? in_sizes[0] : -1, out_size, ws_size); grid = -1; return; }
        int dev = 0, cus = 0, per_cu = 0;
        if (hipGetDevice(&dev) != hipSuccess || hipDeviceGetAttribute(&cus, hipDeviceAttributeMultiprocessorCount, dev) != hipSuccess) { fprintf(stderr, "kernel_launch: device query failed\n"); grid = -1; return; }
        if (hipFuncSetAttribute((const void*)hybrid_fwd, hipFuncAttributeMaxDynamicSharedMemorySize, LDS_BYTES) != hipSuccess) { fprintf(stderr, "kernel_launch: hipFuncSetAttribute failed\n"); grid = -1; return; }
        if (hipOccupancyMaxActiveBlocksPerMultiprocessor(&per_cu, (const void*)hybrid_fwd, NWAVES * 64, LDS_BYTES) != hipSuccess || per_cu < 1) { fprintf(stderr, "kernel_launch: occupancy query reports %d blocks per CU\n", per_cu); per_cu = 1; }
        (void)hipGetLastError();
        grid = cus;
        if (grid > 256) grid = 256;
    }
    if (grid < 0) return;
    if (hipMemsetAsync((char*)d_ws + WS_CTL, 0, CTL_ZERO_BYTES, stream) != hipSuccess) { fprintf(stderr, "kernel_launch: memset failed\n"); return; }
    Args a{};
    for (int i = 0; i < 16; ++i) a.in[i] = d_in[i];
    a.out = (float*)d_out; a.ws = (unsigned char*)d_ws;
    for (int i = 0; i < 32; ++i) a.invf[i] = (float)std::pow(10000.0, -(double)i / 32.0);
    for (int li = 0; li < N_LAUNCHES; ++li) {
        if (DBG_STOP >= 0 && li > DBG_STOP && li != 6) continue;
        a.ph_lo = (N_LAUNCHES == PER_PHASE) ? li : 0; a.ph_hi = (N_LAUNCHES == PER_PHASE) ? li + 1 : PER_PHASE; a.li = li;
        hipLaunchKernelGGL(hybrid_fwd, dim3(grid), dim3(NWAVES * 64), LDS_BYTES, stream, a);
        const hipError_t le = hipPeekAtLastError();
        if (le != hipSuccess) { fprintf(stderr, "kernel_launch: launch %d failed: %s\n", li, hipGetErrorName(le)); break; }
    }
}
```

```cpp
#include <hip/hip_runtime.h>
#include <cstdio>
#include <cstdint>
#include <cmath>
#ifndef MK_N_LAUNCHES
#define MK_N_LAUNCHES 1
#endif
namespace pg8 {
#define PG8_LAS __attribute__((address_space(3)))
typedef unsigned short bf16_t;
typedef short bf16x8 __attribute__((ext_vector_type(8)));
typedef float f32x4 __attribute__((ext_vector_type(4)));
typedef unsigned u32x4 __attribute__((ext_vector_type(4)));
constexpr int BM = 256, BK = 64, HALF = 128, HTB = HALF * BK * 2  , STAGE_BYTES = 8 * HTB, NXCD = 8, WGM = 8;

__host__ __device__ __forceinline__ int lds_byte(int r, int c) { const int st = (r >> 4) * 2 + (c >> 5), rr = r & 15, cc = c & 31, ob = rr * 64 + cc * 2; return st * 1024 + (ob ^ (((ob >> 9) & 1) << 5)); }
__host__ __device__ __forceinline__ void stage_rc(int b, int& R, int& C) { const int st = b / 1024, sb = b % 1024, swz = sb ^ (((sb >> 9) & 1) << 5); R = (st >> 1) * 16 + swz / 64; C = (st & 1) * 32 + (swz % 64) / 2; }
__host__ __device__ __forceinline__ int perm32(int rho) { const int n = rho >> 4, i = rho & 15; return 8 * (i >> 2) + 4 * n + (i & 3); }

struct Unit { int pm, pn; };
struct Gemm { const bf16_t* A; const bf16_t* Bt; int M, N, K; };

struct StaticOrder {
    int nM, nN, nwg, G, c;
    __host__ __device__ void init(int M, int N, int G_, int c_) { nM = M / BM; nN = N / BM; nwg = nM * nN; G = G_; c = c_; }
    __host__ __device__ bool next(int i, Unit& u) const {
        const long L = (long)i * G + c; if (L >= nwg) return false;
        int wgid = (int)L; { const int q = nwg / NXCD, r = nwg % NXCD, xcd = wgid % NXCD, off = wgid / NXCD; wgid = (xcd < r ? xcd * (q + 1) : r * (q + 1) + (xcd - r) * q) + off; }
        const int nig = WGM * nN, gid = wgid / nig, fm = gid * WGM, gsz = (nM - fm) < WGM ? (nM - fm) : WGM;
        u.pm = fm + ((wgid % nig) % gsz); u.pn = (wgid % nig) / gsz; return true;
    }
    __device__ __forceinline__ void a_ready(const Unit&) const {}
    __device__ __forceinline__ void done(const Unit&) const {}
};

typedef float f32x2c __attribute__((ext_vector_type(2))); typedef __bf16 bf16x2c __attribute__((ext_vector_type(2)));
__device__ __forceinline__ unsigned cvt_pk_bf16(float lo, float hi) { f32x2c v = {lo, hi}; bf16x2c b = __builtin_convertvector(v, bf16x2c); return __builtin_bit_cast(unsigned, b); }
typedef float f32x2 __attribute__((ext_vector_type(2)));
__device__ __forceinline__ f32x2 gelu_pk(f32x2 v) {
    const f32x2 av = __builtin_elementwise_abs(v), d = av * 0.2316418882f + 1.0f;
    f32x2 t; t.x = __builtin_amdgcn_rcpf(d.x); t.y = __builtin_amdgcn_rcpf(d.y);
    f32x2 q = t * 0.5307027145f + (-0.7265760135f); q = q * t + 0.7107068705f; q = q * t + (-0.142248368f); q = q * t + 0.127414796f; q = q * t;
    const f32x2 s = (v * v) * (-0.72134752044f);
    f32x2 e; e.x = __builtin_amdgcn_exp2f(s.x); e.y = __builtin_amdgcn_exp2f(s.y);
    const f32x2 m = v * (q * e), r = v - m;
    f32x2 o; o.x = v.x < 0.f ? m.x : r.x; o.y = v.y < 0.f ? m.y : r.y; return o;
}

__device__ __forceinline__ float sigm(float v) { return __builtin_amdgcn_rcpf(1.0f + __builtin_amdgcn_exp2f(-1.4426950408889634f * v)); }
__device__ __forceinline__ f32x4 silu4(f32x4 v) { f32x4 o; o[0] = v[0] * sigm(v[0]); o[1] = v[1] * sigm(v[1]); o[2] = v[2] * sigm(v[2]); o[3] = v[3] * sigm(v[3]); return o; }
__device__ __forceinline__ f32x4 sigm4(f32x4 v) { f32x4 o; o[0] = sigm(v[0]); o[1] = sigm(v[1]); o[2] = sigm(v[2]); o[3] = sigm(v[3]); return o; }
__device__ __forceinline__ f32x4 gelu4(f32x4 v) { const f32x2 a = gelu_pk((f32x2){v[0], v[1]}), b = gelu_pk((f32x2){v[2], v[3]}); return (f32x4){a.x, a.y, b.x, b.y}; }
__device__ __forceinline__ u32x4 pack8(f32x4 a, f32x4 b) { u32x4 w; w.x = cvt_pk_bf16(a[0], a[1]); w.y = cvt_pk_bf16(a[2], a[3]); w.z = cvt_pk_bf16(b[0], b[1]); w.w = cvt_pk_bf16(b[2], b[3]); return w; }
__device__ __forceinline__ float bf_lo(unsigned w) { return __uint_as_float(w << 16); }
__device__ __forceinline__ float bf_hi(unsigned w) { return __uint_as_float(w & 0xffff0000u); }

constexpr float QSCALE = 0.125f * 1.4426950408889634f;

struct EpiProj {
    static constexpr bool PERM = true, AFTER_DRAIN = false, MIDK = false;
    bf16_t *QKV, *ZA, *UZ, *VG, *G; const float *COS, *SIN;
    __device__ __forceinline__ void mid(f32x4 (&)[2][2][4][2], const Unit&, int, int, int, int) const {}
    __device__ __forceinline__ void operator()(const f32x4 (&acc)[2][2][4][2], const Unit& u, int wr, int wc, int fr, int fq) const {
        asm volatile("s_nop 7\n\ts_nop 7\n\ts_nop 3" : "+v"(fr), "+v"(fq));
        const int pn = u.pn, row0 = u.pm * BM + wr * 64 + fr, p0 = wc * 32 + 8 * fq;
#if defined(DBG_TILEMASK)
        { const int ty = pn < 2 ? 0 : pn == 2 ? 1 : pn < 5 ? 2 : pn < 9 ? 3 : pn < 11 ? 4 : 5; if (!((DBG_TILEMASK >> ty) & 1)) return; }
#if defined(DBG_FIRSTONLY)
        { StaticOrder S0; S0.init(32768, 4864, (int)gridDim.x, (int)blockIdx.x); Unit u0; S0.next(DBG_FIRSTONLY, u0); if (!(u0.pm == u.pm && u0.pn == u.pn)) return; }
#endif
#endif
        if (pn < 2 || (pn == 2 && wc < 2)) {
            const int colbase = (pn < 2 ? (4 * pn + wc) * 64 : 512 + wc * 64) + 8 * fq; const float qs = pn < 2 ? QSCALE : 1.0f;
#pragma unroll
            for (int ai = 0; ai < 2; ++ai)
#pragma unroll
                for (int m = 0; m < 4; ++m) { const int row = row0 + ai * HALF + m * 16;
                    const f32x4 c0 = *(const f32x4*)(COS + (size_t)row * 32 + 8 * fq), c1 = *(const f32x4*)(COS + (size_t)row * 32 + 8 * fq + 4);
                    const f32x4 s0 = *(const f32x4*)(SIN + (size_t)row * 32 + 8 * fq), s1 = *(const f32x4*)(SIN + (size_t)row * 32 + 8 * fq + 4);
                    const f32x4 a0 = acc[ai][0][m][0], a1 = acc[ai][0][m][1], b0 = acc[ai][1][m][0], b1 = acc[ai][1][m][1];
                    const f32x4 o10 = (a0 * c0 - b0 * s0) * qs, o11 = (a1 * c1 - b1 * s1) * qs, o20 = (b0 * c0 + a0 * s0) * qs, o21 = (b1 * c1 + a1 * s1) * qs;
                    bf16_t* rp = QKV + (size_t)row * 768 + colbase;
                    *(u32x4*)rp = pack8(o10, o11); *(u32x4*)(rp + 32) = pack8(o20, o21); }
        } else if (pn == 2) {
            const int colbase = 640 + (wc - 2) * 32 + 8 * fq;
#pragma unroll
            for (int ai = 0; ai < 2; ++ai)
#pragma unroll
                for (int m = 0; m < 4; ++m) { bf16_t* rp = QKV + (size_t)(row0 + ai * HALF + m * 16) * 768 + colbase;
#pragma unroll
                    for (int bj = 0; bj < 2; ++bj) *(u32x4*)(rp + bj * 64) = pack8(acc[ai][bj][m][0], acc[ai][bj][m][1]); }
        } else if (pn < 5) {
#pragma unroll
            for (int ai = 0; ai < 2; ++ai)
#pragma unroll
                for (int m = 0; m < 4; ++m) { bf16_t* rp = ZA + (size_t)(row0 + ai * HALF + m * 16) * 512 + (pn - 3) * 256 + p0;
#pragma unroll
                    for (int bj = 0; bj < 2; ++bj) *(u32x4*)(rp + bj * HALF) = pack8(silu4(acc[ai][bj][m][0]), silu4(acc[ai][bj][m][1])); }
        } else if (pn < 9) {
#pragma unroll
            for (int ai = 0; ai < 2; ++ai)
#pragma unroll
                for (int m = 0; m < 4; ++m) { bf16_t* rp = UZ + (size_t)(row0 + ai * HALF + m * 16) * 512 + (pn - 5) * 128 + p0;
                    *(u32x4*)rp = pack8(gelu4(acc[ai][0][m][0]) * silu4(acc[ai][1][m][0]), gelu4(acc[ai][0][m][1]) * silu4(acc[ai][1][m][1])); }
        } else if (pn < 11) {
#pragma unroll
            for (int ai = 0; ai < 2; ++ai)
#pragma unroll
                for (int m = 0; m < 4; ++m) { bf16_t* rp = VG + (size_t)(row0 + ai * HALF + m * 16) * 512 + (pn - 9) * 256 + p0;
#pragma unroll
                    for (int bj = 0; bj < 2; ++bj) *(u32x4*)(rp + bj * HALF) = pack8(gelu4(acc[ai][bj][m][0]), gelu4(acc[ai][bj][m][1])); }
        } else {
#pragma unroll
            for (int ai = 0; ai < 2; ++ai)
#pragma unroll
                for (int m = 0; m < 4; ++m) { bf16_t* rp = G + (size_t)(row0 + ai * HALF + m * 16) * 2048 + (pn - 11) * 256 + p0;
#pragma unroll
                    for (int bj = 0; bj < 2; ++bj) *(u32x4*)(rp + bj * HALF) = pack8(sigm4(acc[ai][bj][m][0]), sigm4(acc[ai][bj][m][1])); }
        }
    }
};

struct EpiMerge {
    static constexpr bool PERM = true, AFTER_DRAIN = false, MIDK = true;
    const bf16_t* G; bf16_t* O;
    __device__ __forceinline__ void mid(f32x4 (&acc)[2][2][4][2], const Unit& u, int wr, int wc, int fr, int fq) const {
        asm volatile("s_nop 7\n\ts_nop 7\n\ts_nop 3" : "+v"(fr), "+v"(fq));
        const int row0 = u.pm * BM + wr * 64 + fr, col0 = u.pn * BM + wc * 32 + 8 * fq;
#pragma unroll
        for (int ai = 0; ai < 2; ++ai)
#pragma unroll
            for (int m = 0; m < 4; ++m) { const bf16_t* gp = G + (size_t)(row0 + ai * HALF + m * 16) * 2048 + col0;
#pragma unroll
                for (int bj = 0; bj < 2; ++bj) { const u32x4 ga = *(const u32x4*)(gp + bj * HALF), gb = *(const u32x4*)(gp + 1024 + bj * HALF);
                    f32x4 r0, r1;
                    r0[0] = bf_lo(ga.x) * __builtin_amdgcn_rcpf(fmaxf(bf_lo(gb.x), 1e-30f)); r0[1] = bf_hi(ga.x) * __builtin_amdgcn_rcpf(fmaxf(bf_hi(gb.x), 1e-30f));
                    r0[2] = bf_lo(ga.y) * __builtin_amdgcn_rcpf(fmaxf(bf_lo(gb.y), 1e-30f)); r0[3] = bf_hi(ga.y) * __builtin_amdgcn_rcpf(fmaxf(bf_hi(gb.y), 1e-30f));
                    r1[0] = bf_lo(ga.z) * __builtin_amdgcn_rcpf(fmaxf(bf_lo(gb.z), 1e-30f)); r1[1] = bf_hi(ga.z) * __builtin_amdgcn_rcpf(fmaxf(bf_hi(gb.z), 1e-30f));
                    r1[2] = bf_lo(ga.w) * __builtin_amdgcn_rcpf(fmaxf(bf_lo(gb.w), 1e-30f)); r1[3] = bf_hi(ga.w) * __builtin_amdgcn_rcpf(fmaxf(bf_hi(gb.w), 1e-30f));
                    acc[ai][bj][m][0] = acc[ai][bj][m][0] * r0; acc[ai][bj][m][1] = acc[ai][bj][m][1] * r1; } }
    }
    __device__ __forceinline__ void operator()(const f32x4 (&acc)[2][2][4][2], const Unit& u, int wr, int wc, int fr, int fq) const {
        asm volatile("s_nop 7\n\ts_nop 7\n\ts_nop 3" : "+v"(fr), "+v"(fq));
        const int row0 = u.pm * BM + wr * 64 + fr, col0 = u.pn * BM + wc * 32 + 8 * fq;
#pragma unroll
        for (int ai = 0; ai < 2; ++ai)
#pragma unroll
            for (int m = 0; m < 4; ++m) { const size_t row = (size_t)(row0 + ai * HALF + m * 16);
#pragma unroll
                for (int bj = 0; bj < 2; ++bj) { const u32x4 gb = *(const u32x4*)(G + row * 2048 + 1024 + col0 + bj * HALF);
                    const f32x4 g0 = (f32x4){bf_lo(gb.x), bf_hi(gb.x), bf_lo(gb.y), bf_hi(gb.y)}, g1 = (f32x4){bf_lo(gb.z), bf_hi(gb.z), bf_lo(gb.w), bf_hi(gb.w)};
                    *(u32x4*)(O + row * 1024 + col0 + bj * HALF) = pack8(acc[ai][bj][m][0] * g0, acc[ai][bj][m][1] * g1); } }
    }
};

struct EpiY {
    static constexpr bool PERM = true, AFTER_DRAIN = false, MIDK = false;
    bf16_t* O; float* RSS;
    __device__ __forceinline__ void mid(f32x4 (&)[2][2][4][2], const Unit&, int, int, int, int) const {}
    __device__ __forceinline__ void operator()(const f32x4 (&acc)[2][2][4][2], const Unit& u, int wr, int wc, int fr, int fq) const {
        asm volatile("s_nop 7\n\ts_nop 7\n\ts_nop 3" : "+v"(fr), "+v"(fq));
        const int row0 = u.pm * BM + wr * 64 + fr, col0 = u.pn * BM + wc * 32 + 8 * fq;
#pragma unroll
        for (int ai = 0; ai < 2; ++ai)
#pragma unroll
            for (int m = 0; m < 4; ++m) { const size_t row = (size_t)(row0 + ai * HALF + m * 16); float q = 0.f;
#pragma unroll
                for (int bj = 0; bj < 2; ++bj) { const f32x4 a = acc[ai][bj][m][0], b = acc[ai][bj][m][1];
                    q += (a[0] * a[0] + a[1] * a[1]) + (a[2] * a[2] + a[3] * a[3]) + (b[0] * b[0] + b[1] * b[1]) + (b[2] * b[2] + b[3] * b[3]);
                    *(u32x4*)(O + row * 1024 + col0 + bj * HALF) = pack8(a, b); }
                q += __shfl_xor(q, 16); q += __shfl_xor(q, 32);
                if (fq == 0) RSS[row * 16 + u.pn * 4 + wc] = q; }
    }
};
template <class Epi, class Sched, bool ALIGN_EPI = false, bool SP2 = false>
__device__ __forceinline__ void gemm_phase(PG8_LAS unsigned char* lds, const Gemm g, const Sched& S, const Epi& E) {
    int tid_ = threadIdx.x; asm volatile("" : "+v"(tid_));
    const int tid = tid_, wid = __builtin_amdgcn_readfirstlane(tid >> 6), lane = tid & 63, wr = wid >> 2, wc = wid & 3, fr = lane & 15, fq = lane >> 4;
    const int K = g.K, nt = K / BK;
    unsigned voffA[2], voffB[2];
#pragma unroll
    for (int i = 0; i < 2; ++i) { int R, C; stage_rc(tid * 16 + i * 8192, R, C); const int Rb = Epi::PERM ? ((R & ~31) + perm32(R & 31)) : R;
        voffA[i] = (unsigned)(R * K + C) * 2u; voffB[i] = (unsigned)(Rb * K + C) * 2u; }
    const size_t kstep = (size_t)(BK * 2);
    const size_t hstep = (size_t)HALF * K * 2;
    const size_t tstep = 2 * hstep;
    const unsigned ldsw = (unsigned)wid * 1024u;
    const int aoff = lds_byte(wr * 64 + fr, fq * 8), boff = lds_byte(wc * 32 + fr, fq * 8);
#define PG8_SA(b, h) (((b) * 2 + (h)) * HTB)
#define PG8_SB(b, h) ((4 + (b) * 2 + (h)) * HTB)
#define PG8_STAGE(bufoff, gbase, voff) do { _Pragma("unroll") for (int _i = 0; _i < 2; ++_i) \
        __builtin_amdgcn_global_load_lds((const unsigned*)((const char*)(gbase) + (voff)[_i]), (PG8_LAS unsigned*)(lds + (bufoff) + ldsw + _i * 8192), 16, 0, 0); } while (0)
#define PG8_LDA(dst, b, h) do { _Pragma("unroll") for (int m = 0; m < 4; ++m) _Pragma("unroll") for (int k = 0; k < 2; ++k) dst[m][k] = *(const PG8_LAS bf16x8*)(lds + PG8_SA(b, h) + aoff + m * 2048 + k * 1024); } while (0)
#define PG8_LDB(dst, b, h) do { _Pragma("unroll") for (int n = 0; n < 2; ++n) _Pragma("unroll") for (int k = 0; k < 2; ++k) dst[n][k] = *(const PG8_LAS bf16x8*)(lds + PG8_SB(b, h) + boff + n * 2048 + k * 1024); } while (0)
#define PG8_MMA(ai, bj, At, Bt) do { __builtin_amdgcn_s_setprio(1); _Pragma("unroll") for (int m = 0; m < 4; ++m) _Pragma("unroll") for (int n = 0; n < 2; ++n) _Pragma("unroll") for (int k = 0; k < 2; ++k) \
        acc[ai][bj][m][n] = __builtin_amdgcn_mfma_f32_16x16x32_bf16(Bt[n][k], At[m][k], acc[ai][bj][m][n], 0, 0, 0); __builtin_amdgcn_s_setprio(0); } while (0)
#define PG8_WAIT_V(n) asm volatile("s_waitcnt vmcnt(" #n ")" ::: "memory")
#define PG8_WAIT_L(n) asm volatile("s_waitcnt lgkmcnt(" #n ")" ::: "memory")
#define PG8_BAR __builtin_amdgcn_s_barrier()
#define PG8_SCHED __builtin_amdgcn_sched_barrier(0)
    Unit cur, nxt; int ui = 0;
    if (!S.next(0, cur)) return;
    f32x4 acc[2][2][4][2];
#pragma unroll
    for (int a = 0; a < 2; ++a)
#pragma unroll
        for (int b = 0; b < 2; ++b)
#pragma unroll
            for (int m = 0; m < 4; ++m)
#pragma unroll
                for (int n = 0; n < 2; ++n) acc[a][b][m][n] = (f32x4){0.f, 0.f, 0.f, 0.f};
    bf16x8 At[4][2], B0[2][2], B1[2][2];
    const char* cA = (const char*)g.A + (size_t)cur.pm * tstep; const char* cB = (const char*)g.Bt + (size_t)cur.pn * tstep;
    S.a_ready(cur);
    if constexpr (SP2) {
        PG8_STAGE(PG8_SB(0, 0), cB, voffB); PG8_STAGE(PG8_SB(0, 1), cB + hstep, voffB); PG8_STAGE(PG8_SA(0, 0), cA, voffA); PG8_STAGE(PG8_SA(0, 1), cA + hstep, voffA);
        if (wr == 1) PG8_BAR;
        PG8_WAIT_V(2); PG8_BAR;
        PG8_STAGE(PG8_SB(1, 0), cB + kstep, voffB); PG8_STAGE(PG8_SA(1, 0), cA + kstep, voffA); PG8_STAGE(PG8_SB(1, 1), cB + hstep + kstep, voffB);
        PG8_WAIT_V(6); PG8_BAR;
    } else {
        PG8_STAGE(PG8_SB(0, 0), cB, voffB); PG8_STAGE(PG8_SA(0, 0), cA, voffA); PG8_STAGE(PG8_SB(0, 1), cB + hstep, voffB); PG8_STAGE(PG8_SA(0, 1), cA + hstep, voffA);
        if (wr == 1) PG8_BAR;
        PG8_WAIT_V(4); PG8_BAR;
        PG8_STAGE(PG8_SB(1, 0), cB + kstep, voffB); PG8_STAGE(PG8_SA(1, 0), cA + kstep, voffA); PG8_STAGE(PG8_SB(1, 1), cB + hstep + kstep, voffB);
        PG8_WAIT_V(6); PG8_BAR;
    }
    for (;;) {
        const bool has_next = S.next(ui + 1, nxt);
        const char* nA = has_next ? (const char*)g.A + (size_t)nxt.pm * tstep : cA; const char* nB = has_next ? (const char*)g.Bt + (size_t)nxt.pn * tstep : cB;
        for (int t = 0; t < nt; t += 2) {
            if constexpr (Epi::MIDK) { if (t == (nt >> 1)) E.mid(acc, cur, wr, wc, fr, fq); }
            const bool last = (t == nt - 2);
            const char* a1 = cA + (size_t)(t + 1) * kstep;
            const char* a2 = last ? nA : cA + (size_t)(t + 2) * kstep; const char* b2 = last ? nB : cB + (size_t)(t + 2) * kstep;
            const char* a3 = a2 + kstep; const char* b3 = b2 + kstep;
            if (last && has_next) S.a_ready(nxt);
            if constexpr (SP2) {
            PG8_LDB(B0, 0, 0); PG8_LDB(B1, 0, 1); PG8_SCHED; PG8_LDA(At, 0, 0); PG8_STAGE(PG8_SA(1, 1), a1 + hstep, voffA);
            PG8_WAIT_V(8); PG8_WAIT_L(0); PG8_BAR; PG8_MMA(0, 0, At, B0); PG8_MMA(0, 1, At, B1); PG8_BAR; PG8_SCHED;
            PG8_LDA(At, 0, 1); PG8_STAGE(PG8_SB(0, 0), b2, voffB); PG8_STAGE(PG8_SB(0, 1), b2 + hstep, voffB); PG8_STAGE(PG8_SA(0, 0), a2, voffA);
            PG8_WAIT_V(8); PG8_WAIT_L(0); PG8_BAR; PG8_MMA(1, 0, At, B0); PG8_MMA(1, 1, At, B1); PG8_BAR; PG8_SCHED;
            PG8_LDB(B0, 1, 0); PG8_LDB(B1, 1, 1); PG8_SCHED; PG8_LDA(At, 1, 0); PG8_STAGE(PG8_SA(0, 1), a2 + hstep, voffA);
            PG8_WAIT_V(8); PG8_WAIT_L(0); PG8_BAR; PG8_MMA(0, 0, At, B0); PG8_MMA(0, 1, At, B1); PG8_BAR; PG8_SCHED;
            PG8_LDA(At, 1, 1); PG8_STAGE(PG8_SB(1, 0), b3, voffB); PG8_STAGE(PG8_SB(1, 1), b3 + hstep, voffB); PG8_STAGE(PG8_SA(1, 0), a3, voffA);
            PG8_WAIT_V(8); PG8_WAIT_L(0); PG8_BAR; PG8_MMA(1, 0, At, B0); PG8_MMA(1, 1, At, B1); PG8_BAR; PG8_SCHED;
            } else {
            PG8_LDB(B0, 0, 0); PG8_SCHED; PG8_LDA(At, 0, 0); PG8_STAGE(PG8_SA(1, 1), a1 + hstep, voffA);
            PG8_WAIT_L(8); PG8_BAR; PG8_WAIT_L(0); PG8_MMA(0, 0, At, B0); PG8_BAR; PG8_SCHED;
            PG8_LDB(B1, 0, 1); PG8_STAGE(PG8_SB(0, 0), b2, voffB);
            PG8_BAR; PG8_WAIT_L(0); PG8_MMA(0, 1, At, B1); PG8_BAR;
            PG8_LDA(At, 0, 1); PG8_STAGE(PG8_SA(0, 0), a2, voffA);
            PG8_BAR; PG8_WAIT_L(0); PG8_MMA(1, 0, At, B0); PG8_BAR; PG8_SCHED;
            PG8_STAGE(PG8_SB(0, 1), b2 + hstep, voffB);
            PG8_WAIT_V(6); PG8_BAR; PG8_MMA(1, 1, At, B1); PG8_BAR;
            PG8_LDB(B0, 1, 0); PG8_SCHED; PG8_LDA(At, 1, 0); PG8_STAGE(PG8_SA(0, 1), a2 + hstep, voffA);
            PG8_WAIT_L(8); PG8_BAR; PG8_WAIT_L(0); PG8_MMA(0, 0, At, B0); PG8_BAR; PG8_SCHED;
            PG8_LDB(B1, 1, 1); PG8_STAGE(PG8_SB(1, 0), b3, voffB);
            PG8_BAR; PG8_WAIT_L(0); PG8_MMA(0, 1, At, B1); PG8_BAR;
            PG8_LDA(At, 1, 1); PG8_STAGE(PG8_SA(1, 0), a3, voffA);
            PG8_BAR; PG8_WAIT_L(0); PG8_MMA(1, 0, At, B0); PG8_BAR; PG8_SCHED;
            PG8_STAGE(PG8_SB(1, 1), b3 + hstep, voffB);
            PG8_WAIT_V(6); PG8_BAR; PG8_MMA(1, 1, At, B1); PG8_BAR;
            }
        }
        if constexpr (ALIGN_EPI) { if (wr == 0) PG8_BAR; }
        if constexpr (!Epi::AFTER_DRAIN) { E(acc, cur, wr, wc, fr, fq); S.done(cur); }
        if (!has_next) break;
#pragma unroll
        for (int a = 0; a < 2; ++a)
#pragma unroll
            for (int b = 0; b < 2; ++b)
#pragma unroll
                for (int m = 0; m < 4; ++m)
#pragma unroll
                    for (int n = 0; n < 2; ++n) acc[a][b][m][n] = (f32x4){0.f, 0.f, 0.f, 0.f};
        cur = nxt; cA = nA; cB = nB; ++ui;
        if constexpr (ALIGN_EPI) { if (wr == 1) PG8_BAR; }
    }
    PG8_WAIT_V(0);
    if constexpr (!ALIGN_EPI) { if (wr == 0) PG8_BAR; }
    PG8_BAR;
    if constexpr (Epi::AFTER_DRAIN) { E.fused(acc, cur, wr, wc, fr, fq, lds, wid, lane); S.done(cur); }
#undef PG8_SA
#undef PG8_SB
#undef PG8_STAGE
#undef PG8_LDA
#undef PG8_LDB
#undef PG8_MMA
#undef PG8_WAIT_V
#undef PG8_WAIT_L
#undef PG8_BAR
#undef PG8_SCHED
}
}
#define GAS __attribute__((address_space(1)))
#define LAS __attribute__((address_space(3)))
typedef unsigned short bf16;
typedef unsigned v4u __attribute__((ext_vector_type(4)));
typedef float f32x4 __attribute__((ext_vector_type(4)));
typedef short bf16x8 __attribute__((ext_vector_type(8)));
typedef GAS unsigned gu32;
typedef GAS unsigned long long gu64;
#define RLX_AGENT __ATOMIC_RELAXED, __HIP_MEMORY_SCOPE_AGENT
#define LDS_WAIT() asm volatile("s_waitcnt lgkmcnt(0)" ::: "memory")
#define VM_WAIT() asm volatile("s_waitcnt vmcnt(0)" ::: "memory")
__device__ __forceinline__ unsigned long long rt() { return __builtin_amdgcn_s_memrealtime(); }
__device__ __forceinline__ unsigned f2bf(float f) { unsigned u = __builtin_bit_cast(unsigned, f); return (u + 0x7fffu + ((u >> 16) & 1u)) >> 16; }
__device__ __forceinline__ unsigned pk2(float lo, float hi) { return f2bf(lo) | (f2bf(hi) << 16); }

#define XB_TMO      128
#define XB_XCNT(j)  (256  + 64 * (j))
#define XB_XSUB(j)  (1280 + 64 * (j))
#define XB_XGEN(j)  (2304 + 64 * (j))
#define XB_TOP      3328
#define XB_TOPGEN   3392
#define XCD_BAR_WORDS 3456
#define XB_SPIN_CAP (1u << 18)

__device__ __forceinline__ unsigned xb_ld(unsigned* p)              { return __hip_atomic_load(p, __ATOMIC_RELAXED, __HIP_MEMORY_SCOPE_AGENT); }
__device__ __forceinline__ unsigned xb_add(unsigned* p, unsigned v) { return __hip_atomic_fetch_add(p, v, __ATOMIC_RELAXED, __HIP_MEMORY_SCOPE_AGENT); }
__device__ __forceinline__ unsigned xb_xcc_id() { return (unsigned)__builtin_amdgcn_s_getreg((3 << 11) | 20) & 0xFu; }
#define XB_SPIN(cond, bar) do { unsigned _sp = 0; while (cond) { __builtin_amdgcn_s_sleep(1); \
    if ((++_sp & 255u) == 0u) { if (xb_ld(&(bar)[XB_TMO])) break; if (_sp > XB_SPIN_CAP) { atomicAdd(&(bar)[XB_TMO], 1u); break; } } } } while (0)

struct XcdBarrier {
    unsigned* bar; unsigned x;
    volatile LAS unsigned* st;
};

__device__ __forceinline__ XcdBarrier xcd_barrier_post(unsigned* bar, volatile LAS unsigned* st) {
    XcdBarrier b; b.bar = bar; b.x = xb_xcc_id(); b.st = st;
    if (threadIdx.x == 0) (void)xb_add(&bar[XB_XCNT(b.x)], 1u);
    return b;
}
__device__ __forceinline__ void xcd_barrier_complete(unsigned* bar, unsigned x, unsigned& nloc, unsigned& nx) {
    const unsigned G = gridDim.x * gridDim.y * gridDim.z;
    unsigned sum, cnt, mine, sp = 0u;
    for (;;) {
        sum = 0u; cnt = 0u; mine = 0u;
#pragma unroll
        for (unsigned j = 0; j < 16; ++j) { const unsigned c = xb_ld(&bar[XB_XCNT(j)]); sum += c; cnt += (c > 0u) ? 1u : 0u; mine = (j == x) ? c : mine; }
        if (sum == G) break;
        __builtin_amdgcn_s_sleep(1);
        if ((++sp & 255u) == 0u) { if (xb_ld(&bar[XB_TMO])) break; if (sp > XB_SPIN_CAP) { atomicAdd(&bar[XB_TMO], 1u); break; } }
    }
    nloc = mine > 0u ? mine : 1u; nx = cnt > 0u ? cnt : 1u;
}

__device__ __forceinline__ void xcd_barrier(const XcdBarrier& b) {
    asm volatile("s_waitcnt vmcnt(0)" ::: "memory");
    __syncthreads();
    if (threadIdx.x == 0) {
        unsigned* bar = b.bar;
        __builtin_amdgcn_s_waitcnt(0);
        unsigned nloc = b.st[0], nx = b.st[1];
        if (nloc == 0u) { xcd_barrier_complete(bar, b.x, nloc, nx); b.st[0] = nloc; b.st[1] = nx; }
        const unsigned old = xb_add(&bar[XB_XSUB(b.x)], 1u);
        const unsigned gen = old / nloc;
        if (old + 1u == (gen + 1u) * nloc) {
            __builtin_amdgcn_fence(__ATOMIC_RELEASE, "agent");
            asm volatile("s_waitcnt vmcnt(0)" ::: "memory");
            const unsigned og = xb_add(&bar[XB_TOP], 1u);
            const unsigned tg = og / nx;
            if (og + 1u == (tg + 1u) * nx) xb_add(&bar[XB_TOPGEN], 1u);
            else XB_SPIN(xb_ld(&bar[XB_TOPGEN]) == tg, bar);
            __builtin_amdgcn_fence(__ATOMIC_ACQUIRE, "agent");
            xb_add(&bar[XB_XGEN(b.x)], 1u);
            asm volatile("s_waitcnt vmcnt(0)" ::: "memory");
        } else {
            XB_SPIN(xb_ld(&bar[XB_XGEN(b.x)]) == gen, bar);
            __builtin_amdgcn_fence(__ATOMIC_ACQUIRE, "agent");
            asm volatile("s_waitcnt vmcnt(0)" ::: "memory");
        }
    }
    __syncthreads();
}

constexpr int NWAVES = 8;
constexpr int N_LAUNCHES = MK_N_LAUNCHES;
constexpr int PER_PHASE = 7;
constexpr int BATCH = 8, SEQ = 4096, DM = 1024, M = BATCH * SEQ;
constexpr int D_IN = 4864, NBLK = M / 128;
constexpr float EPS = 1e-6f;

constexpr size_t MiB = 1u << 20;
constexpr size_t WS_CTL = 0, CTL_ZERO_BYTES = 64 * 1024;
constexpr size_t WS_WIN = 2 * MiB;
constexpr size_t WS_WP = 12 * MiB;
constexpr size_t WS_WO = 14 * MiB;
constexpr size_t WS_WS = 16 * MiB;
constexpr size_t WS_ADA = 16 * MiB + 512 * 1024;
constexpr size_t WS_COS = 18 * MiB, WS_SIN = 22 * MiB;
constexpr size_t WS_RSS = 26 * MiB;
constexpr size_t WS_H = 32 * MiB;
constexpr size_t WS_QKV = 96 * MiB;
constexpr size_t WS_ZA = 144 * MiB;
constexpr size_t WS_UZ = 176 * MiB;
constexpr size_t WS_VG = 208 * MiB;
constexpr size_t WS_G = 240 * MiB;
constexpr size_t WS_MRG = 368 * MiB;
constexpr size_t WS_END = 432 * MiB;
constexpr int CW_BAR = 1024;

constexpr int RING_OFF = 0, RING_BYTES = 131072;
constexpr int LDSCTL_OFF = RING_BYTES, MISC_OFF = LDSCTL_OFF + 320;
constexpr int LDS_BYTES = 147456;

struct Frame {
    LAS unsigned char* lds;
    volatile LAS unsigned* MISC;
    gu32* ctl;
    int tid, lane, wave;
    int vcu, G;
    const float *x, *c, *w_ada, *b_ada, *g_pre, *g_post, *w_in, *sinks, *ln_g, *ln_b, *w_s, *b_s, *w_pa, *w_pb, *w_out;
    const int* pos;
    float* out;
    bf16 *WinT, *WpT, *WoT, *WsB, *H, *QKV, *ZA, *UZ, *VG, *GT, *MRG;
    float *ADA, *COS, *SIN, *RSS;
};

__device__ __forceinline__ float wave_sum(float v) {
#pragma unroll
    for (int o = 1; o < 64; o <<= 1) v += __shfl_xor(v, o);
    return v;
}
__device__ __forceinline__ float bfl(unsigned w) { return __uint_as_float(w << 16); }
__device__ __forceinline__ float bfh(unsigned w) { return __uint_as_float(w & 0xffff0000u); }
__device__ __forceinline__ float sigmf(float v) { return __builtin_amdgcn_rcpf(1.0f + __builtin_amdgcn_exp2f(-1.4426950408889634f * v)); }

__device__ __forceinline__ int proj_logical_col(int np) {
    const int pn = np >> 8, p = np & 255, bj = p >> 7, w = (p >> 5) & 3, dd = p & 31;
    if (pn < 2) return (4 * pn + w) * 64 + bj * 32 + dd;
    if (pn == 2) return w < 2 ? 512 + w * 64 + bj * 32 + dd : 640 + bj * 64 + (w - 2) * 32 + dd;
    if (pn < 5) return 768 + (pn - 3) * 256 + p;
    if (pn < 9) return (bj == 0 ? 1280 : 2304) + (pn - 5) * 128 + (p & 127);
    if (pn < 11) return 1792 + (pn - 9) * 256 + p;
    return 2816 + (pn - 11) * 256 + p;
}

__device__ __forceinline__ void p0_transpose_item(const float* W, int Nsrc, int k0, int csrc, bf16* WT, int ldk, int ndst, int kdst, LAS float* scr, int lane) {
#pragma unroll 8
    for (int i = 0; i < 32; ++i) { const int kk = 2 * i + (lane >> 5); scr[kk * 33 + (lane & 31)] = W[(size_t)(k0 + kk) * Nsrc + csrc + (lane & 31)]; }
    LDS_WAIT(); asm volatile("" ::: "memory");
    const int c = lane & 7;
#pragma unroll
    for (int j = 0; j < 4; ++j) { const int n = (lane >> 3) + 8 * j; const LAS float* s = scr + (8 * c) * 33 + n;
        v4u o; o.x = pk2(s[0 * 33], s[1 * 33]); o.y = pk2(s[2 * 33], s[3 * 33]); o.z = pk2(s[4 * 33], s[5 * 33]); o.w = pk2(s[6 * 33], s[7 * 33]);
        *(GAS v4u*)(WT + (size_t)(ndst + n) * ldk + kdst + 8 * c) = o; }
    LDS_WAIT(); asm volatile("" ::: "memory");
}

__device__ __forceinline__ void sincos_acc(float a, float& s, float& c) {
    const double x = (double)a;
    const double kd = rint(x * 0.63661977236758134);
    double r = fma(-kd, 1.5707963267948966, x); r = fma(-kd, 6.123233995736766e-17, r);
    const int q = ((int)kd) & 3;
    const double r2 = r * r;
    const double sp = r * (1.0 + r2 * (-1.0 / 6.0 + r2 * (1.0 / 120.0 + r2 * (-1.0 / 5040.0 + r2 * (1.0 / 362880.0 + r2 * (-1.0 / 39916800.0))))));
    const double cp = 1.0 + r2 * (-0.5 + r2 * (1.0 / 24.0 + r2 * (-1.0 / 720.0 + r2 * (1.0 / 40320.0 + r2 * (-1.0 / 3628800.0 + r2 * (1.0 / 479001600.0))))));
    const double ss = (q & 1) ? cp : sp, cc = (q & 1) ? sp : cp;
    s = (float)((q & 2) ? -ss : ss);
    c = (float)(((q + 1) & 2) ? -cc : cc);
}

__device__ __forceinline__ void p0_prologue(Frame& F, const float* invf  ) {
    const int gw = F.vcu * NWAVES + F.wave, NGW = F.G * NWAVES;
    {
        LAS float* cs = (LAS float*)(F.lds);
        LAS float* red = (LAS float*)(F.lds + 32768);
        for (int i = F.tid; i < BATCH * DM; i += NWAVES * 64) { const float v = F.c[i]; cs[i] = v * sigmf(v); }
        __syncthreads();
        for (int cb = F.vcu; cb < 256; cb += F.G) {
            const int j = F.tid % 12, kg = F.tid / 12;
            float a[BATCH];
#pragma unroll
            for (int b = 0; b < BATCH; ++b) a[b] = 0.f;
            if (kg < 42) for (int k = kg; k < DM; k += 42) { const float w = F.w_ada[(size_t)k * 3072 + cb * 12 + j];
#pragma unroll
                for (int b = 0; b < BATCH; ++b) a[b] += cs[b * DM + k] * w; }
            if (kg < 42) {
#pragma unroll
                for (int b = 0; b < BATCH; ++b) red[(kg * 12 + j) * 8 + b] = a[b]; }
            __syncthreads();
            if (F.tid < 96) { const int jj = F.tid >> 3, b = F.tid & 7; float s = 0.f;
                for (int g = 0; g < 42; ++g) s += red[(g * 12 + jj) * 8 + b];
                F.ADA[b * 3072 + cb * 12 + jj] = s + F.b_ada[cb * 12 + jj]; }
            __syncthreads();
        }
    }
    {
        LAS float* scr = (LAS float*)(F.lds + RING_OFF + F.wave * 16384);
        constexpr int I_IN = 16 * (D_IN / 32), I_P = 8 * 32, I_O = 16 * 32;
        constexpr int NITEMS = I_IN + 2 * I_P + I_O;
        for (int it = gw; it < NITEMS; it += NGW) {
            int r = it;
            if (r < I_IN) { const int nb = r % (D_IN / 32), kb = r / (D_IN / 32); p0_transpose_item(F.w_in, D_IN, 64 * kb, proj_logical_col(32 * nb), F.WinT, 1024, 32 * nb, 64 * kb, scr, F.lane); continue; } r -= I_IN;
            if (r < I_P) { const int nb = r % 32, kb = r / 32; p0_transpose_item(F.w_pa, 1024, 64 * kb, 32 * nb, F.WpT, 1024, 32 * nb, 64 * kb, scr, F.lane); continue; } r -= I_P;
            if (r < I_P) { const int nb = r % 32, kb = r / 32; p0_transpose_item(F.w_pb, 1024, 64 * kb, 32 * nb, F.WpT, 1024, 32 * nb, 512 + 64 * kb, scr, F.lane); continue; } r -= I_P;
            { const int nb = r % 32, kb = r / 32; p0_transpose_item(F.w_out, 1024, 64 * kb, 32 * nb, F.WoT, 1024, 32 * nb, 64 * kb, scr, F.lane); }
        }
    }
    const int gt = F.vcu * (NWAVES * 64) + F.tid, NGT = F.G * NWAVES * 64;
    for (int i = gt; i < 4 * 128 * 128; i += NGT) { const int s = i & 127, t = (i >> 7) & 127; F.WsB[i] = (bf16)(s <= t ? f2bf(F.w_s[i]) : 0u); }
    for (int i = gt; i < M * 32; i += NGT) { const int tok = i >> 5, fi = i & 31; const float ang = (float)F.pos[tok] * invf[fi]; float s, c; sincos_acc(ang, s, c); F.COS[i] = c; F.SIN[i] = s; }
}

__device__ __forceinline__ void p1_prenorm(Frame& F) {
    const int gw = F.vcu * NWAVES + F.wave, NGW = F.G * NWAVES;
    for (int m = gw; m < M; m += NGW) {
        const int b = m / SEQ;
        const GAS f32x4* xr = (const GAS f32x4*)(F.x + (size_t)m * DM) + F.lane;
        f32x4 v[4]; float s2 = 0.f;
#pragma unroll
        for (int j = 0; j < 4; ++j) { v[j] = xr[64 * j]; s2 += (v[j].x * v[j].x + v[j].y * v[j].y) + (v[j].z * v[j].z + v[j].w * v[j].w); }
        const float rstd = 1.f / sqrtf(wave_sum(s2) * (1.f / DM) + EPS);
        GAS unsigned long long* o8 = (GAS unsigned long long*)(F.H + (size_t)m * DM) + F.lane;
#pragma unroll
        for (int j = 0; j < 4; ++j) { const int col = 4 * F.lane + 256 * j;
            const f32x4 g = *(const f32x4*)(F.g_pre + col), sh = *(const f32x4*)(F.ADA + b * 3072 + col), sc = *(const f32x4*)(F.ADA + b * 3072 + 1024 + col);
            const f32x4 h = v[j] * rstd * g * (sc + 1.0f) + sh;
            o8[64 * j] = (unsigned long long)pk2(h.x, h.y) | ((unsigned long long)pk2(h.z, h.w) << 32); }
    }
}

__device__ __forceinline__ void p6_postnorm(Frame& F) {
    const int gw = F.vcu * NWAVES + F.wave, NGW = F.G * NWAVES;
    for (int m = gw; m < M; m += NGW) {
        const int b = m / SEQ;
        const float part = F.lane < 16 ? F.RSS[(size_t)m * 16 + F.lane] : 0.f;
        const float rstd = 1.f / sqrtf(wave_sum(part) * (1.f / DM) + EPS);
        const GAS f32x4* xr = (const GAS f32x4*)(F.x + (size_t)m * DM) + F.lane;
        const GAS unsigned long long* yr = (const GAS unsigned long long*)(F.H + (size_t)m * DM) + F.lane;
        GAS f32x4* orow = (GAS f32x4*)(F.out + (size_t)m * DM) + F.lane;
#pragma unroll
        for (int j = 0; j < 4; ++j) { const int col = 4 * F.lane + 256 * j;
            const f32x4 xv = xr[64 * j]; const unsigned long long yw = yr[64 * j];
            const f32x4 g = *(const f32x4*)(F.g_post + col), gt = *(const f32x4*)(F.ADA + b * 3072 + 2048 + col);
            const f32x4 y = (f32x4){bfl((unsigned)yw), bfh((unsigned)yw), bfl((unsigned)(yw >> 32)), bfh((unsigned)(yw >> 32))};
            orow[64 * j] = xv + gt * (y * rstd * g); }
    }
}

typedef float f32x16 __attribute__((ext_vector_type(16)));
typedef unsigned u32x2 __attribute__((ext_vector_type(2)));
typedef float f32x2_t __attribute__((ext_vector_type(2))); typedef __bf16 bf16x2_t __attribute__((ext_vector_type(2)));
__device__ __forceinline__ unsigned cvtpk(float lo, float hi) { f32x2_t v = {lo, hi}; bf16x2_t b = __builtin_convertvector(v, bf16x2_t); return __builtin_bit_cast(unsigned, b); }
constexpr int KS_PITCH = 144, VT_PITCH = 520, KS_BYTES = 256 * KS_PITCH, VT_OFF = KS_BYTES;
constexpr int VN_PITCH = 272, VN_BYTES = 128 * VN_PITCH, ST_OFF = 2 * VN_BYTES;

__device__ __forceinline__ void attn_block(Frame& F, int blk) {
    const int nb = blk & 31, base = blk * 128, lane = F.lane, q = lane & 31, h = lane >> 5;
    LAS unsigned char* Ks = F.lds; LAS unsigned char* Vt = F.lds + VT_OFF;
    for (int kvh = 0; kvh < 2; ++kvh) {
#pragma unroll
        for (int i = 0; i < 4; ++i) { const int id = F.tid + 512 * i, key = id >> 3, ch = id & 7; const bool ok = (nb > 0) || (key >= 128);
            const size_t row = (size_t)(base - 128 + key);
            v4u kv = (v4u){0u, 0u, 0u, 0u}, vv = (v4u){0u, 0u, 0u, 0u};
            if (ok) { kv = *(const GAS v4u*)(F.QKV + row * 768 + 512 + kvh * 64 + ch * 8); vv = *(const GAS v4u*)(F.QKV + row * 768 + 640 + kvh * 64 + ch * 8); }
            *(LAS v4u*)(Ks + key * KS_PITCH + ch * 16) = kv;
            LAS unsigned short* vp = (LAS unsigned short*)(Vt + (ch * 8) * VT_PITCH + key * 2);
            vp[0 * (VT_PITCH / 2)] = (unsigned short)(vv.x & 0xffffu); vp[1 * (VT_PITCH / 2)] = (unsigned short)(vv.x >> 16);
            vp[2 * (VT_PITCH / 2)] = (unsigned short)(vv.y & 0xffffu); vp[3 * (VT_PITCH / 2)] = (unsigned short)(vv.y >> 16);
            vp[4 * (VT_PITCH / 2)] = (unsigned short)(vv.z & 0xffffu); vp[5 * (VT_PITCH / 2)] = (unsigned short)(vv.z >> 16);
            vp[6 * (VT_PITCH / 2)] = (unsigned short)(vv.w & 0xffffu); vp[7 * (VT_PITCH / 2)] = (unsigned short)(vv.w >> 16); }
        __syncthreads();
        const int g = F.wave >> 1, hq = kvh * 4 + g;
        const float sink2 = F.sinks[hq] * 1.4426950408889634f;
#pragma unroll 1
        for (int t = 0; t < 2; ++t) {
            const int qi = 2 * (F.wave & 1) + t; const size_t row = (size_t)(base + 32 * qi + q);
            bf16x8 qf[4];
#pragma unroll
            for (int ks = 0; ks < 4; ++ks) qf[ks] = *(const GAS bf16x8*)(F.QKV + row * 768 + hq * 64 + 16 * ks + 8 * h);
            f32x16 S[5];
#pragma unroll
            for (int kt = 0; kt < 5; ++kt) {
                f32x16 a = (f32x16){0.f, 0.f, 0.f, 0.f, 0.f, 0.f, 0.f, 0.f, 0.f, 0.f, 0.f, 0.f, 0.f, 0.f, 0.f, 0.f};
#pragma unroll
                for (int ks = 0; ks < 4; ++ks) { const bf16x8 kf = *(const LAS bf16x8*)(Ks + (32 * (qi + kt) + q) * KS_PITCH + (16 * ks + 8 * h) * 2);
                    a = __builtin_amdgcn_mfma_f32_32x32x16_bf16(kf, qf[ks], a, 0, 0, 0); }
                S[kt] = a; }
            float mx = sink2;
#pragma unroll
            for (int kt = 0; kt < 5; ++kt) { const bool tile_ok = (nb > 0) || (qi + kt >= 4);
#pragma unroll
                for (int r = 0; r < 16; ++r) { const int krow = (r & 3) + 8 * (r >> 2) + 4 * h; const int jrel = 32 * kt + krow - q;
                    const bool ok = tile_ok && (jrel > 0) && (jrel <= 128);
                    S[kt][r] = ok ? S[kt][r] : -INFINITY; mx = fmaxf(mx, S[kt][r]); } }
            mx = fmaxf(mx, __shfl_xor(mx, 32));
            float ls = 0.f;
#pragma unroll
            for (int kt = 0; kt < 5; ++kt)
#pragma unroll
                for (int r = 0; r < 16; ++r) { const float p = __builtin_amdgcn_exp2f(S[kt][r] - mx); S[kt][r] = p; ls += p; }
            ls += __shfl_xor(ls, 32);
            const float rl = 1.0f / (ls + __builtin_amdgcn_exp2f(sink2 - mx));
            f32x16 O[2];
#pragma unroll
            for (int dt = 0; dt < 2; ++dt) O[dt] = (f32x16){0.f, 0.f, 0.f, 0.f, 0.f, 0.f, 0.f, 0.f, 0.f, 0.f, 0.f, 0.f, 0.f, 0.f, 0.f, 0.f};
#pragma unroll
            for (int kt = 0; kt < 5; ++kt)
#pragma unroll
                for (int s = 0; s < 2; ++s) {
                    v4u pw; pw.x = cvtpk(S[kt][8 * s + 0], S[kt][8 * s + 1]); pw.y = cvtpk(S[kt][8 * s + 2], S[kt][8 * s + 3]); pw.z = cvtpk(S[kt][8 * s + 4], S[kt][8 * s + 5]); pw.w = cvtpk(S[kt][8 * s + 6], S[kt][8 * s + 7]);
                    const bf16x8 pf = __builtin_bit_cast(bf16x8, pw);
#pragma unroll
                    for (int dt = 0; dt < 2; ++dt) { const LAS unsigned char* vp = Vt + (32 * dt + q) * VT_PITCH + (32 * (qi + kt) + 16 * s + 4 * h) * 2;
                        const u32x2 lo = *(const LAS u32x2*)vp, hi = *(const LAS u32x2*)(vp + 16);
                        const v4u vw = (v4u){lo.x, lo.y, hi.x, hi.y};
                        O[dt] = __builtin_amdgcn_mfma_f32_32x32x16_bf16(__builtin_bit_cast(bf16x8, vw), pf, O[dt], 0, 0, 0); } }
#pragma unroll
            for (int dt = 0; dt < 2; ++dt)
#pragma unroll
                for (int r4 = 0; r4 < 4; ++r4) { const int d0 = 32 * dt + 8 * r4 + 4 * h;
                    const u32x2 zw = *(const GAS u32x2*)(F.ZA + row * 512 + hq * 64 + d0);
                    u32x2 ow; ow.x = cvtpk(O[dt][4 * r4 + 0] * rl * bfl(zw.x), O[dt][4 * r4 + 1] * rl * bfh(zw.x)); ow.y = cvtpk(O[dt][4 * r4 + 2] * rl * bfl(zw.y), O[dt][4 * r4 + 3] * rl * bfh(zw.y));
                    *(GAS u32x2*)(F.H + row * 1024 + hq * 64 + d0) = ow; }
        }
        __syncthreads();
    }
}

__device__ __forceinline__ void gmlp_block(Frame& F, int blk) {
    const int base = blk * 128, lane = F.lane;
    LAS float* ST = (LAS float*)(F.lds + ST_OFF);
#pragma unroll 4
    for (int i = 0; i < 16; ++i) { const int tk = 16 * F.wave + i;
        const v4u w = *(const GAS v4u*)(F.VG + (size_t)(base + tk) * 512 + 8 * lane);
        const float v0 = bfl(w.x), v1 = bfh(w.x), v2 = bfl(w.y), v3 = bfh(w.y), v4 = bfl(w.z), v5 = bfh(w.z), v6 = bfl(w.w), v7 = bfh(w.w);
        const float mean = wave_sum(((v0 + v1) + (v2 + v3)) + ((v4 + v5) + (v6 + v7))) * (1.f / 512.f);
        const float d0 = v0 - mean, d1 = v1 - mean, d2 = v2 - mean, d3 = v3 - mean, d4 = v4 - mean, d5 = v5 - mean, d6 = v6 - mean, d7 = v7 - mean;
        const float var = wave_sum(((d0 * d0 + d1 * d1) + (d2 * d2 + d3 * d3)) + ((d4 * d4 + d5 * d5) + (d6 * d6 + d7 * d7))) * (1.f / 512.f);
        if (lane == 0) { ST[2 * tk] = mean; ST[2 * tk + 1] = 1.f / sqrtf(var + EPS); } }
    __syncthreads();
#pragma unroll 1
    for (int gp = 0; gp < 2; ++gp) {
        { const int g2 = F.tid >> 8, co = (F.tid >> 4) & 15, so = F.tid & 15, ch0 = (2 * gp + g2) * 128 + 8 * co;
            const f32x4 ga = *(const f32x4*)(F.ln_g + ch0), gb = *(const f32x4*)(F.ln_g + ch0 + 4), ba = *(const f32x4*)(F.ln_b + ch0), bb = *(const f32x4*)(F.ln_b + ch0 + 4);
            float vn[8][8];
#pragma unroll
            for (int i = 0; i < 8; ++i) { const int tk = 8 * so + i; const v4u w = *(const GAS v4u*)(F.VG + (size_t)(base + tk) * 512 + ch0);
                const float mean = ST[2 * tk], rstd = ST[2 * tk + 1];
                vn[i][0] = (bfl(w.x) - mean) * rstd * ga[0] + ba[0]; vn[i][1] = (bfh(w.x) - mean) * rstd * ga[1] + ba[1]; vn[i][2] = (bfl(w.y) - mean) * rstd * ga[2] + ba[2]; vn[i][3] = (bfh(w.y) - mean) * rstd * ga[3] + ba[3];
                vn[i][4] = (bfl(w.z) - mean) * rstd * gb[0] + bb[0]; vn[i][5] = (bfh(w.z) - mean) * rstd * gb[1] + bb[1]; vn[i][6] = (bfl(w.w) - mean) * rstd * gb[2] + bb[2]; vn[i][7] = (bfh(w.w) - mean) * rstd * gb[3] + bb[3]; }
            LAS unsigned char* dst = F.lds + g2 * VN_BYTES + (8 * co) * VN_PITCH + so * 16;
#pragma unroll
            for (int cc = 0; cc < 8; ++cc) { v4u o; o.x = cvtpk(vn[0][cc], vn[1][cc]); o.y = cvtpk(vn[2][cc], vn[3][cc]); o.z = cvtpk(vn[4][cc], vn[5][cc]); o.w = cvtpk(vn[6][cc], vn[7][cc]);
                *(LAS v4u*)(dst + cc * VN_PITCH) = o; } }
        __syncthreads();
        { const int g2 = F.wave >> 2, cj = F.wave & 3, g = 2 * gp + g2, t = lane & 31, h = lane >> 5;
            f32x16 acc[4];
#pragma unroll
            for (int ti = 0; ti < 4; ++ti) acc[ti] = (f32x16){0.f, 0.f, 0.f, 0.f, 0.f, 0.f, 0.f, 0.f, 0.f, 0.f, 0.f, 0.f, 0.f, 0.f, 0.f, 0.f};
            const LAS unsigned char* ap = F.lds + g2 * VN_BYTES + (32 * cj + t) * VN_PITCH + 16 * h;
            const bf16* wp = F.WsB + (size_t)g * 16384 + (size_t)t * 128 + 8 * h;
#pragma unroll
            for (int ks = 0; ks < 8; ++ks) { const bf16x8 af = *(const LAS bf16x8*)(ap + 32 * ks);
#pragma unroll
                for (int ti = 0; ti < 4; ++ti) if (2 * (ti + 1) > ks) { const bf16x8 bfr = *(const GAS bf16x8*)(wp + (size_t)ti * 4096 + 16 * ks);
                    acc[ti] = __builtin_amdgcn_mfma_f32_32x32x16_bf16(af, bfr, acc[ti], 0, 0, 0); } }
#pragma unroll
            for (int ti = 0; ti < 4; ++ti) { const int tk = 32 * ti + t; const float bs = F.b_s[g * 128 + tk]; const size_t row = (size_t)(base + tk);
#pragma unroll
                for (int r4 = 0; r4 < 4; ++r4) { const int c0 = g * 128 + 32 * cj + 8 * r4 + 4 * h;
                    const u32x2 uw = *(const GAS u32x2*)(F.UZ + row * 512 + c0);
                    u32x2 ow; ow.x = cvtpk((acc[ti][4 * r4 + 0] + bs) * bfl(uw.x), (acc[ti][4 * r4 + 1] + bs) * bfh(uw.x)); ow.y = cvtpk((acc[ti][4 * r4 + 2] + bs) * bfl(uw.y), (acc[ti][4 * r4 + 3] + bs) * bfh(uw.y));
                    *(GAS u32x2*)(F.H + row * 1024 + 512 + c0) = ow; } } }
        __syncthreads();
    }
}

__device__ __forceinline__ void naive_mixers(Frame& F, int blk) {
    const int nb = blk & 31, base = blk * 128, lane = F.lane;
    for (int it = F.wave; it < 128 * 8; it += NWAVES) { const int i = it >> 3, hq = it & 7, kvh = hq >> 2; const size_t row = (size_t)(base + i);
        const float qd = bfl((unsigned)F.QKV[row * 768 + hq * 64 + lane]);
        const float sink2 = F.sinks[hq] * 1.4426950408889634f;
        float m = sink2, l = 1.0f, o = 0.f;
        int j0 = i - 127; if (nb == 0 && j0 < 0) j0 = 0;
        for (int j = j0; j <= i; ++j) { const size_t kr = (size_t)(base + j);
            const float s = wave_sum(qd * bfl((unsigned)F.QKV[kr * 768 + 512 + kvh * 64 + lane]));
            const float mn = fmaxf(m, s), sc = exp2f(m - mn), p = exp2f(s - mn);
            l = l * sc + p; o = o * sc + p * bfl((unsigned)F.QKV[kr * 768 + 640 + kvh * 64 + lane]); m = mn; }
        const float y = o / l * bfl((unsigned)F.ZA[row * 512 + hq * 64 + lane]);
        F.H[row * 1024 + hq * 64 + lane] = (bf16)f2bf(y); }
    LAS float* ST = (LAS float*)(F.lds);
    __syncthreads();
    if (F.tid < 128) { const size_t row = (size_t)(base + F.tid); float s = 0.f; for (int c = 0; c < 512; ++c) s += bfl((unsigned)F.VG[row * 512 + c]);
        const float mean = s / 512.f; float q = 0.f; for (int c = 0; c < 512; ++c) { const float dlt = bfl((unsigned)F.VG[row * 512 + c]) - mean; q += dlt * dlt; }
        ST[2 * F.tid] = mean; ST[2 * F.tid + 1] = 1.f / sqrtf(q / 512.f + EPS); }
    __syncthreads();
    for (int it = F.tid; it < 128 * 512; it += NWAVES * 64) { const int t = it >> 9, ch = it & 511, g = ch >> 7; float acc = 0.f;
        for (int s = 0; s <= t; ++s) { const float vn = (bfl((unsigned)F.VG[(size_t)(base + s) * 512 + ch]) - ST[2 * s]) * ST[2 * s + 1] * F.ln_g[ch] + F.ln_b[ch];
            acc += F.w_s[(g * 128 + t) * 128 + s] * vn; }
        const float y = (acc + F.b_s[g * 128 + t]) * bfl((unsigned)F.UZ[(size_t)(base + t) * 512 + ch]);
        F.H[(size_t)(base + t) * 1024 + 512 + ch] = (bf16)f2bf(y); }
    __syncthreads();
}

__device__ __forceinline__ float naive_dot_in(Frame& F, size_t row, int c) { float a = 0.f; for (int k = 0; k < DM; ++k) a += bfl((unsigned)F.H[row * 1024 + k]) * F.w_in[(size_t)k * D_IN + c]; return a; }
__device__ __forceinline__ float gelu_exact(float v) { return 0.5f * v * (1.0f + erff(v * 0.70710678118654752f)); }
__device__ __forceinline__ void naive_proj(Frame& F) {
    const size_t gt = (size_t)F.vcu * (NWAVES * 64) + F.tid, NGT = (size_t)F.G * NWAVES * 64;
    for (size_t it = gt; it < (size_t)M * 4352; it += NGT) { const size_t row = it / 4352; const int j = (int)(it % 4352);
        if (j < 640) { const int d = j & 63, dd = d & 31; const int c1 = (j & ~63) + dd, c2 = c1 + 32;
            const float t1 = naive_dot_in(F, row, c1), t2 = naive_dot_in(F, row, c2), cs = F.COS[row * 32 + dd], sn = F.SIN[row * 32 + dd];
            float o = d < 32 ? t1 * cs - t2 * sn : t2 * cs + t1 * sn; if (j < 512) o *= 0.125f * 1.4426950408889634f;
            F.QKV[row * 768 + j] = (bf16)f2bf(o); }
        else if (j < 768) F.QKV[row * 768 + j] = (bf16)f2bf(naive_dot_in(F, row, j));
        else if (j < 1280) { const float v = naive_dot_in(F, row, j); F.ZA[row * 512 + (j - 768)] = (bf16)f2bf(v * sigmf(v)); }
        else if (j < 1792) { const float u = naive_dot_in(F, row, j), z = naive_dot_in(F, row, j + 1024); F.UZ[row * 512 + (j - 1280)] = (bf16)f2bf(gelu_exact(u) * z * sigmf(z)); }
        else if (j < 2304) { const float v = naive_dot_in(F, row, j); F.VG[row * 512 + (j - 1792)] = (bf16)f2bf(gelu_exact(v)); }
        else { const float v = naive_dot_in(F, row, j + 512); F.GT[row * 2048 + (j - 2304)] = (bf16)f2bf(sigmf(v)); } }
}
__device__ __forceinline__ void naive_merge(Frame& F) {
    const size_t gt = (size_t)F.vcu * (NWAVES * 64) + F.tid, NGT = (size_t)F.G * NWAVES * 64;
    for (size_t it = gt; it < (size_t)M * DM; it += NGT) { const size_t row = it >> 10; const int n = (int)(it & 1023); float a = 0.f, b = 0.f;
        for (int k = 0; k < 512; ++k) { a += bfl((unsigned)F.H[row * 1024 + k]) * F.w_pa[(size_t)k * 1024 + n]; b += bfl((unsigned)F.H[row * 1024 + 512 + k]) * F.w_pb[(size_t)k * 1024 + n]; }
        F.MRG[it] = (bf16)f2bf(bfl((unsigned)F.GT[row * 2048 + n]) * a + bfl((unsigned)F.GT[row * 2048 + 1024 + n]) * b); }
}
__device__ __forceinline__ void naive_out(Frame& F) {
    LAS float* red = (LAS float*)F.lds;
    for (int row = F.vcu; row < M; row += F.G) { float q = 0.f;
        for (int n = F.tid; n < DM; n += NWAVES * 64) { float a = 0.f; for (int k = 0; k < DM; ++k) a += bfl((unsigned)F.MRG[(size_t)row * 1024 + k]) * F.w_out[(size_t)k * 1024 + n];
            F.H[(size_t)row * 1024 + n] = (bf16)f2bf(a); q += a * a; }
        q = wave_sum(q); if (F.lane == 0) red[F.wave] = q; __syncthreads();
        if (F.tid < 16) F.RSS[(size_t)row * 16 + F.tid] = F.tid == 0 ? ((red[0] + red[1]) + (red[2] + red[3])) + ((red[4] + red[5]) + (red[6] + red[7])) : 0.f;
        __syncthreads(); }
}

struct Args { const void* in[16]; float* out; unsigned char* ws; float invf[32]; int ph_lo, ph_hi, li, pad; };

typedef const __attribute__((address_space(4))) Args* KArgs;
__device__ __forceinline__ void fresh_tid(Frame& F) { int t = threadIdx.x; asm volatile("" : "+v"(t)); F.tid = t; F.lane = t & 63; }
__device__ __forceinline__ KArgs fresh_args() { KArgs p = (KArgs)__builtin_amdgcn_kernarg_segment_ptr(); asm volatile("" : "+s"(p)); return p; }
__device__ __forceinline__ void fill_frame(Frame& F, KArgs a) {
    unsigned char* ws = a->ws;
    F.x = (const float*)a->in[0]; F.c = (const float*)a->in[1]; F.pos = (const int*)a->in[2]; F.w_ada = (const float*)a->in[3]; F.b_ada = (const float*)a->in[4];
    F.g_pre = (const float*)a->in[5]; F.g_post = (const float*)a->in[6]; F.w_in = (const float*)a->in[7]; F.sinks = (const float*)a->in[8];
    F.ln_g = (const float*)a->in[9]; F.ln_b = (const float*)a->in[10]; F.w_s = (const float*)a->in[11]; F.b_s = (const float*)a->in[12];
    F.w_pa = (const float*)a->in[13]; F.w_pb = (const float*)a->in[14]; F.w_out = (const float*)a->in[15]; F.out = a->out;
    F.WinT = (bf16*)(ws + WS_WIN); F.WpT = (bf16*)(ws + WS_WP); F.WoT = (bf16*)(ws + WS_WO); F.WsB = (bf16*)(ws + WS_WS);
    F.H = (bf16*)(ws + WS_H); F.QKV = (bf16*)(ws + WS_QKV); F.ZA = (bf16*)(ws + WS_ZA); F.UZ = (bf16*)(ws + WS_UZ); F.VG = (bf16*)(ws + WS_VG); F.GT = (bf16*)(ws + WS_G); F.MRG = (bf16*)(ws + WS_MRG);
    F.ADA = (float*)(ws + WS_ADA); F.COS = (float*)(ws + WS_COS); F.SIN = (float*)(ws + WS_SIN); F.RSS = (float*)(ws + WS_RSS);
}

#ifndef DBG_STOP
#define DBG_STOP -1
#endif
__device__ __forceinline__ float bf2f(bf16 v) { return __uint_as_float((unsigned)v << 16); }
__device__ __forceinline__ void dbg_dump(Frame& F) {
    const size_t gt = (size_t)F.vcu * (NWAVES * 64) + F.tid, NGT = (size_t)F.G * NWAVES * 64, NOUT = (size_t)M * DM;
    for (size_t i = gt; i < NOUT; i += NGT) {
        float v = 0.f;
        if (DBG_STOP == 0) v = bf2f(F.WinT[i % ((size_t)D_IN * 1024)]) + bf2f(F.WpT[i % (1024 * 1024)]) + bf2f(F.WoT[i % (1024 * 1024)]) + bf2f(F.WsB[i % 65536]) + F.ADA[i % 24576] + F.COS[i % ((size_t)M * 32)] + F.SIN[i % ((size_t)M * 32)];
        if (DBG_STOP == 1 || DBG_STOP == 3) v = bf2f(F.H[i]);
        if (DBG_STOP == 2) v = bf2f(F.GT[2 * i]) + 2.f * bf2f(F.GT[2 * i + 1]) + bf2f(F.QKV[i % ((size_t)M * 768)]) + bf2f(F.ZA[i % ((size_t)M * 512)]) + bf2f(F.UZ[i % ((size_t)M * 512)]) + bf2f(F.VG[i % ((size_t)M * 512)]);
        if (DBG_STOP == 4) v = bf2f(F.MRG[i]);
        if (DBG_STOP == 5) v = bf2f(F.H[i]) + F.RSS[i % ((size_t)M * 16)];
        F.out[i] = v;
    }
}
__global__ void __launch_bounds__(NWAVES * 64, 2) hybrid_fwd(Args args) {
    extern __shared__ __attribute__((aligned(16))) unsigned char lds[];
    Frame F;
    F.lds = (LAS unsigned char*)lds;
    F.MISC = (volatile LAS unsigned*)(F.lds + MISC_OFF);
    F.tid = threadIdx.x; F.lane = F.tid & 63; F.wave = __builtin_amdgcn_readfirstlane(F.tid >> 6);
    F.G = gridDim.x; { const int bx = blockIdx.x; F.vcu = (F.G % 8 == 0) ? (bx % 8) * (F.G / 8) + bx / 8 : bx; }
    F.ctl = (gu32*)(args.ws + WS_CTL);
    for (int u = F.tid; u < (LDS_BYTES - LDSCTL_OFF) / 4; u += NWAVES * 64) ((LAS unsigned*)(F.lds + LDSCTL_OFF))[u] = 0u;
    __syncthreads();
    if (F.tid < 32) ((LAS float*)(F.lds + LDSCTL_OFF + 1024))[F.tid] = args.invf[F.tid];
    __syncthreads();
    XcdBarrier bar; bar.bar = (unsigned*)(F.ctl + CW_BAR); bar.x = 0; bar.st = nullptr;
    if (N_LAUNCHES != PER_PHASE) bar = xcd_barrier_post((unsigned*)(F.ctl + CW_BAR), F.MISC + 8);
#define GRID_BAR() do { if (N_LAUNCHES != PER_PHASE) xcd_barrier(bar); } while (0)
    const int lo = args.ph_lo, hi = args.ph_hi;
#define IN(k) (lo <= (k) && (k) < hi)
#define BOTH(k) (IN(k) && IN((k) + 1))
    if (IN(0)) { fill_frame(F, fresh_args()); fresh_tid(F); p0_prologue(F, (const float*)(lds + LDSCTL_OFF + 1024)); if (BOTH(0)) GRID_BAR(); }
    if (IN(1)) { fill_frame(F, fresh_args()); fresh_tid(F); p1_prenorm(F); if (BOTH(1)) GRID_BAR(); }
    if (IN(2)) { fill_frame(F, fresh_args()); fresh_tid(F);
#if defined(NAIVE_P2)
        naive_proj(F);
#endif
#if defined(DBG_TILEMASK)
        GRID_BAR();
#endif
#if !defined(NAIVE_P2) || defined(DBG_TILEMASK)
        pg8::Gemm g{F.H, F.WinT, M, D_IN, DM}; pg8::StaticOrder S; S.init(M, D_IN, F.G, (int)blockIdx.x);
        pg8::EpiProj E{F.QKV, F.ZA, F.UZ, F.VG, F.GT, F.COS, F.SIN};
        pg8::gemm_phase<pg8::EpiProj, pg8::StaticOrder, true, true>(F.lds + RING_OFF, g, S, E);
#endif
        if (BOTH(2)) GRID_BAR();
    }
    if (IN(3)) { fill_frame(F, fresh_args()); fresh_tid(F);
#if defined(NAIVE_P3)
        for (int blk = F.vcu; blk < NBLK; blk += F.G) naive_mixers(F, blk);
#else
        for (int blk = F.vcu; blk < NBLK; blk += F.G) { attn_block(F, blk); gmlp_block(F, blk); }
#endif
        if (BOTH(3)) GRID_BAR();
    }
    if (IN(4)) { fill_frame(F, fresh_args()); fresh_tid(F);
#if defined(NAIVE_P45)
        naive_merge(F);
#else
        pg8::Gemm g{F.H, F.WpT, M, DM, DM}; pg8::StaticOrder S; S.init(M, DM, F.G, (int)blockIdx.x);
        pg8::EpiMerge E{F.GT, F.MRG};
        pg8::gemm_phase<pg8::EpiMerge, pg8::StaticOrder, true, true>(F.lds + RING_OFF, g, S, E);
#endif
        if (BOTH(4)) GRID_BAR();
    }
    if (IN(5)) { fill_frame(F, fresh_args()); fresh_tid(F);
#if defined(NAIVE_P45)
        naive_out(F);
#else
        pg8::Gemm g{F.MRG, F.WoT, M, DM, DM}; pg8::StaticOrder S; S.init(M, DM, F.G, (int)blockIdx.x);
        pg8::EpiY E{F.H, F.RSS};
        pg8::gemm_phase<pg8::EpiY, pg8::StaticOrder, true, true>(F.lds + RING_OFF, g, S, E);
#endif
        if (BOTH(5)) GRID_BAR();
    }
    if (IN(6)) { fill_frame(F, fresh_args()); fresh_tid(F); if (DBG_STOP >= 0) dbg_dump(F); else p6_postnorm(F); }
#undef IN
#undef BOTH
}

extern "C" void kernel_launch(void* const* d_in, const int* in_sizes, int n_in, void* d_out, int out_size, void* d_ws, size_t ws_size, hipStream_t stream) {
    static int grid = 0;
    if (grid == 0) {
        if (n_in != 16 || in_sizes[0] != M * DM || out_size != M * DM || ws_size < WS_END) { fprintf(stderr, "kernel_launch: unexpected shapes (n_in %d, in0 %d, out %d, ws %zu); nothing launched\n", n_in, n_in > 0 ? in_sizes[0] : -1, out_size, ws_size); grid = -1; return; }
        int dev = 0, cus = 0, per_cu = 0;
        if (hipGetDevice(&dev) != hipSuccess || hipDeviceGetAttribute(&cus, hipDeviceAttributeMultiprocessorCount, dev) != hipSuccess) { fprintf(stderr, "kernel_launch: device query failed\n"); grid = -1; return; }
        if (hipFuncSetAttribute((const void*)hybrid_fwd, hipFuncAttributeMaxDynamicSharedMemorySize, LDS_BYTES) != hipSuccess) { fprintf(stderr, "kernel_launch: hipFuncSetAttribute failed\n"); grid = -1; return; }
        if (hipOccupancyMaxActiveBlocksPerMultiprocessor(&per_cu, (const void*)hybrid_fwd, NWAVES * 64, LDS_BYTES) != hipSuccess || per_cu < 1) { fprintf(stderr, "kernel_launch: occupancy query reports %d blocks per CU\n", per_cu); per_cu = 1; }
        (void)hipGetLastError();
        grid = cus;
        if (grid > 256) grid = 256;
    }
    if (grid < 0) return;
    if (hipMemsetAsync((char*)d_ws + WS_CTL, 0, CTL_ZERO_BYTES, stream) != hipSuccess) { fprintf(stderr, "kernel_launch: memset failed\n"); return; }
    Args a{};
    for (int i = 0; i < 16; ++i) a.in[i] = d_in[i];
    a.out = (float*)d_out; a.ws = (unsigned char*)d_ws;
    for (int i = 0; i < 32; ++i) a.invf[i] = (float)std::pow(10000.0, -(double)i / 32.0);
    for (int li = 0; li < N_LAUNCHES; ++li) {
        if (DBG_STOP >= 0 && li > DBG_STOP && li != 6) continue;
        a.ph_lo = (N_LAUNCHES == PER_PHASE) ? li : 0; a.ph_hi = (N_LAUNCHES == PER_PHASE) ? li + 1 : PER_PHASE; a.li = li;
        hipLaunchKernelGGL(hybrid_fwd, dim3(grid), dim3(NWAVES * 64), LDS_BYTES, stream, a);
        const hipError_t le = hipPeekAtLastError();
        if (le != hipSuccess) { fprintf(stderr, "kernel_launch: launch %d failed: %s\n", li, hipGetErrorName(le)); break; }
    }
}
```

```cpp
#include <hip/hip_runtime.h>
#include <cstdio>
#include <cstdint>
#include <cmath>
#ifndef MK_N_LAUNCHES
#define MK_N_LAUNCHES 1
#endif
namespace pg8 {
#define PG8_LAS __attribute__((address_space(3)))
typedef unsigned short bf16_t;
typedef short bf16x8 __attribute__((ext_vector_type(8)));
typedef float f32x4 __attribute__((ext_vector_type(4)));
typedef unsigned u32x4 __attribute__((ext_vector_type(4)));
constexpr int BM = 256, BK = 64, HALF = 128, HTB = HALF * BK * 2  , STAGE_BYTES = 8 * HTB, NXCD = 8, WGM = 8;

__host__ __device__ __forceinline__ int lds_byte(int r, int c) { const int st = (r >> 4) * 2 + (c >> 5), rr = r & 15, cc = c & 31, ob = rr * 64 + cc * 2; return st * 1024 + (ob ^ (((ob >> 9) & 1) << 5)); }
__host__ __device__ __forceinline__ void stage_rc(int b, int& R, int& C) { const int st = b / 1024, sb = b % 1024, swz = sb ^ (((sb >> 9) & 1) << 5); R = (st >> 1) * 16 + swz / 64; C = (st & 1) * 32 + (swz % 64) / 2; }
__host__ __device__ __forceinline__ int perm32(int rho) { const int n = rho >> 4, i = rho & 15; return 8 * (i >> 2) + 4 * n + (i & 3); }

struct Unit { int pm, pn; };
struct Gemm { const bf16_t* A; const bf16_t* Bt; int M, N, K; };

struct StaticOrder {
    int nM, nN, nwg, G, c;
    __host__ __device__ void init(int M, int N, int G_, int c_) { nM = M / BM; nN = N / BM; nwg = nM * nN; G = G_; c = c_; }
    __host__ __device__ bool next(int i, Unit& u) const {
        const long L = (long)i * G + c; if (L >= nwg) return false;
        int wgid = (int)L; { const int q = nwg / NXCD, r = nwg % NXCD, xcd = wgid % NXCD, off = wgid / NXCD; wgid = (xcd < r ? xcd * (q + 1) : r * (q + 1) + (xcd - r) * q) + off; }
        const int nig = WGM * nN, gid = wgid / nig, fm = gid * WGM, gsz = (nM - fm) < WGM ? (nM - fm) : WGM;
        u.pm = fm + ((wgid % nig) % gsz); u.pn = (wgid % nig) / gsz; return true;
    }
    __device__ __forceinline__ void a_ready(const Unit&) const {}
    __device__ __forceinline__ void done(const Unit&) const {}
};

typedef float f32x2c __attribute__((ext_vector_type(2))); typedef __bf16 bf16x2c __attribute__((ext_vector_type(2)));
__device__ __forceinline__ unsigned cvt_pk_bf16(float lo, float hi) { f32x2c v = {lo, hi}; bf16x2c b = __builtin_convertvector(v, bf16x2c); return __builtin_bit_cast(unsigned, b); }
typedef float f32x2 __attribute__((ext_vector_type(2)));
__device__ __forceinline__ f32x2 gelu_pk(f32x2 v) {
    const f32x2 av = __builtin_elementwise_abs(v), d = av * 0.2316418882f + 1.0f;
    f32x2 t; t.x = __builtin_amdgcn_rcpf(d.x); t.y = __builtin_amdgcn_rcpf(d.y);
    f32x2 q = t * 0.5307027145f + (-0.7265760135f); q = q * t + 0.7107068705f; q = q * t + (-0.142248368f); q = q * t + 0.127414796f; q = q * t;
    const f32x2 s = (v * v) * (-0.72134752044f);
    f32x2 e; e.x = __builtin_amdgcn_exp2f(s.x); e.y = __builtin_amdgcn_exp2f(s.y);
    const f32x2 m = v * (q * e), r = v - m;
    f32x2 o; o.x = v.x < 0.f ? m.x : r.x; o.y = v.y < 0.f ? m.y : r.y; return o;
}

__device__ __forceinline__ float sigm(float v) { return __builtin_amdgcn_rcpf(1.0f + __builtin_amdgcn_exp2f(-1.4426950408889634f * v)); }
__device__ __forceinline__ f32x4 silu4(f32x4 v) { f32x4 o; o[0] = v[0] * sigm(v[0]); o[1] = v[1] * sigm(v[1]); o[2] = v[2] * sigm(v[2]); o[3] = v[3] * sigm(v[3]); return o; }
__device__ __forceinline__ f32x4 sigm4(f32x4 v) { f32x4 o; o[0] = sigm(v[0]); o[1] = sigm(v[1]); o[2] = sigm(v[2]); o[3] = sigm(v[3]); return o; }
__device__ __forceinline__ f32x4 gelu4(f32x4 v) { const f32x2 a = gelu_pk((f32x2){v[0], v[1]}), b = gelu_pk((f32x2){v[2], v[3]}); return (f32x4){a.x, a.y, b.x, b.y}; }
__device__ __forceinline__ u32x4 pack8(f32x4 a, f32x4 b) { u32x4 w; w.x = cvt_pk_bf16(a[0], a[1]); w.y = cvt_pk_bf16(a[2], a[3]); w.z = cvt_pk_bf16(b[0], b[1]); w.w = cvt_pk_bf16(b[2], b[3]); return w; }
__device__ __forceinline__ float bf_lo(unsigned w) { return __uint_as_float(w << 16); }
__device__ __forceinline__ float bf_hi(unsigned w) { return __uint_as_float(w & 0xffff0000u); }

constexpr float QSCALE = 0.125f * 1.4426950408889634f;

struct EpiProj {
    static constexpr bool PERM = true, AFTER_DRAIN = false, MIDK = false;
    bf16_t *QKV, *ZA, *UZ, *VG, *G; const float *COS, *SIN;
    __device__ __forceinline__ void mid(f32x4 (&)[2][2][4][2], const Unit&, int, int, int, int) const {}
    __device__ __forceinline__ void operator()(const f32x4 (&acc)[2][2][4][2], const Unit& u, int wr, int wc, int fr, int fq) const {
        asm volatile("s_nop 7\n\ts_nop 7\n\ts_nop 3" : "+v"(fr), "+v"(fq));
        const int pn = u.pn, row0 = u.pm * BM + wr * 64 + fr, p0 = wc * 32 + 8 * fq;
#if defined(DBG_TILEMASK)
        { const int ty = pn < 2 ? 0 : pn == 2 ? 1 : pn < 5 ? 2 : pn < 9 ? 3 : pn < 11 ? 4 : 5; if (!((DBG_TILEMASK >> ty) & 1)) return; }
#if defined(DBG_FIRSTONLY)
        { StaticOrder S0; S0.init(32768, 4864, (int)gridDim.x, (int)blockIdx.x); Unit u0; S0.next(DBG_FIRSTONLY, u0); if (!(u0.pm == u.pm && u0.pn == u.pn)) return; }
#endif
#endif
        if (pn < 2 || (pn == 2 && wc < 2)) {
            const int colbase = (pn < 2 ? (4 * pn + wc) * 64 : 512 + wc * 64) + 8 * fq; const float qs = pn < 2 ? QSCALE : 1.0f;
#pragma unroll
            for (int ai = 0; ai < 2; ++ai)
#pragma unroll
                for (int m = 0; m < 4; ++m) { const int row = row0 + ai * HALF + m * 16;
                    const f32x4 c0 = *(const f32x4*)(COS + (size_t)row * 32 + 8 * fq), c1 = *(const f32x4*)(COS + (size_t)row * 32 + 8 * fq + 4);
                    const f32x4 s0 = *(const f32x4*)(SIN + (size_t)row * 32 + 8 * fq), s1 = *(const f32x4*)(SIN + (size_t)row * 32 + 8 * fq + 4);
                    const f32x4 a0 = acc[ai][0][m][0], a1 = acc[ai][0][m][1], b0 = acc[ai][1][m][0], b1 = acc[ai][1][m][1];
                    const f32x4 o10 = (a0 * c0 - b0 * s0) * qs, o11 = (a1 * c1 - b1 * s1) * qs, o20 = (b0 * c0 + a0 * s0) * qs, o21 = (b1 * c1 + a1 * s1) * qs;
                    bf16_t* rp = QKV + (size_t)row * 768 + colbase;
                    *(u32x4*)rp = pack8(o10, o11); *(u32x4*)(rp + 32) = pack8(o20, o21); }
        } else if (pn == 2) {
            const int colbase = 640 + (wc - 2) * 32 + 8 * fq;
#pragma unroll
            for (int ai = 0; ai < 2; ++ai)
#pragma unroll
                for (int m = 0; m < 4; ++m) { bf16_t* rp = QKV + (size_t)(row0 + ai * HALF + m * 16) * 768 + colbase;
#pragma unroll
                    for (int bj = 0; bj < 2; ++bj) *(u32x4*)(rp + bj * 64) = pack8(acc[ai][bj][m][0], acc[ai][bj][m][1]); }
        } else if (pn < 5) {
#pragma unroll
            for (int ai = 0; ai < 2; ++ai)
#pragma unroll
                for (int m = 0; m < 4; ++m) { bf16_t* rp = ZA + (size_t)(row0 + ai * HALF + m * 16) * 512 + (pn - 3) * 256 + p0;
#pragma unroll
                    for (int bj = 0; bj < 2; ++bj) *(u32x4*)(rp + bj * HALF) = pack8(silu4(acc[ai][bj][m][0]), silu4(acc[ai][bj][m][1])); }
        } else if (pn < 9) {
#pragma unroll
            for (int ai = 0; ai < 2; ++ai)
#pragma unroll
                for (int m = 0; m < 4; ++m) { bf16_t* rp = UZ + (size_t)(row0 + ai * HALF + m * 16) * 512 + (pn - 5) * 128 + p0;
                    *(u32x4*)rp = pack8(gelu4(acc[ai][0][m][0]) * silu4(acc[ai][1][m][0]), gelu4(acc[ai][0][m][1]) * silu4(acc[ai][1][m][1])); }
        } else if (pn < 11) {
#pragma unroll
            for (int ai = 0; ai < 2; ++ai)
#pragma unroll
                for (int m = 0; m < 4; ++m) { bf16_t* rp = VG + (size_t)(row0 + ai * HALF + m * 16) * 512 + (pn - 9) * 256 + p0;
#pragma unroll
                    for (int bj = 0; bj < 2; ++bj) *(u32x4*)(rp + bj * HALF) = pack8(gelu4(acc[ai][bj][m][0]), gelu4(acc[ai][bj][m][1])); }
        } else {
#pragma unroll
            for (int ai = 0; ai < 2; ++ai)
#pragma unroll
                for (int m = 0; m < 4; ++m) { bf16_t* rp = G + (size_t)(row0 + ai * HALF + m * 16) * 2048 + (pn - 11) * 256 + p0;
#pragma unroll
                    for (int bj = 0; bj < 2; ++bj) *(u32x4*)(rp + bj * HALF) = pack8(sigm4(acc[ai][bj][m][0]), sigm4(acc[ai][bj][m][1])); }
        }
    }
};

struct EpiMerge {
    static constexpr bool PERM = true, AFTER_DRAIN = false, MIDK = true;
    const bf16_t* G; bf16_t* O;
    __device__ __forceinline__ void mid(f32x4 (&acc)[2][2][4][2], const Unit& u, int wr, int wc, int fr, int fq) const {
        asm volatile("s_nop 7\n\ts_nop 7\n\ts_nop 3" : "+v"(fr), "+v"(fq));
        const int row0 = u.pm * BM + wr * 64 + fr, col0 = u.pn * BM + wc * 32 + 8 * fq;
#pragma unroll
        for (int ai = 0; ai < 2; ++ai)
#pragma unroll
            for (int m = 0; m < 4; ++m) { const bf16_t* gp = G + (size_t)(row0 + ai * HALF + m * 16) * 2048 + col0;
#pragma unroll
                for (int bj = 0; bj < 2; ++bj) { const u32x4 ga = *(const u32x4*)(gp + bj * HALF), gb = *(const u32x4*)(gp + 1024 + bj * HALF);
                    f32x4 r0, r1;
                    r0[0] = bf_lo(ga.x) * __builtin_amdgcn_rcpf(fmaxf(bf_lo(gb.x), 1e-30f)); r0[1] = bf_hi(ga.x) * __builtin_amdgcn_rcpf(fmaxf(bf_hi(gb.x), 1e-30f));
                    r0[2] = bf_lo(ga.y) * __builtin_amdgcn_rcpf(fmaxf(bf_lo(gb.y), 1e-30f)); r0[3] = bf_hi(ga.y) * __builtin_amdgcn_rcpf(fmaxf(bf_hi(gb.y), 1e-30f));
                    r1[0] = bf_lo(ga.z) * __builtin_amdgcn_rcpf(fmaxf(bf_lo(gb.z), 1e-30f)); r1[1] = bf_hi(ga.z) * __builtin_amdgcn_rcpf(fmaxf(bf_hi(gb.z), 1e-30f));
                    r1[2] = bf_lo(ga.w) * __builtin_amdgcn_rcpf(fmaxf(bf_lo(gb.w), 1e-30f)); r1[3] = bf_hi(ga.w) * __builtin_amdgcn_rcpf(fmaxf(bf_hi(gb.w), 1e-30f));
                    acc[ai][bj][m][0] = acc[ai][bj][m][0] * r0; acc[ai][bj][m][1] = acc[ai][bj][m][1] * r1; } }
    }
    __device__ __forceinline__ void operator()(const f32x4 (&acc)[2][2][4][2], const Unit& u, int wr, int wc, int fr, int fq) const {
        asm volatile("s_nop 7\n\ts_nop 7\n\ts_nop 3" : "+v"(fr), "+v"(fq));
        const int row0 = u.pm * BM + wr * 64 + fr, col0 = u.pn * BM + wc * 32 + 8 * fq;
#pragma unroll
        for (int ai = 0; ai < 2; ++ai)
#pragma unroll
            for (int m = 0; m < 4; ++m) { const size_t row = (size_t)(row0 + ai * HALF + m * 16);
#pragma unroll
                for (int bj = 0; bj < 2; ++bj) { const u32x4 gb = *(const u32x4*)(G + row * 2048 + 1024 + col0 + bj * HALF);
                    const f32x4 g0 = (f32x4){bf_lo(gb.x), bf_hi(gb.x), bf_lo(gb.y), bf_hi(gb.y)}, g1 = (f32x4){bf_lo(gb.z), bf_hi(gb.z), bf_lo(gb.w), bf_hi(gb.w)};
                    *(u32x4*)(O + row * 1024 + col0 + bj * HALF) = pack8(acc[ai][bj][m][0] * g0, acc[ai][bj][m][1] * g1); } }
    }
};

struct EpiY {
    static constexpr bool PERM = true, AFTER_DRAIN = false, MIDK = false;
    bf16_t* O; float* RSS;
    __device__ __forceinline__ void mid(f32x4 (&)[2][2][4][2], const Unit&, int, int, int, int) const {}
    __device__ __forceinline__ void operator()(const f32x4 (&acc)[2][2][4][2], const Unit& u, int wr, int wc, int fr, int fq) const {
        asm volatile("s_nop 7\n\ts_nop 7\n\ts_nop 3" : "+v"(fr), "+v"(fq));
        const int row0 = u.pm * BM + wr * 64 + fr, col0 = u.pn * BM + wc * 32 + 8 * fq;
#pragma unroll
        for (int ai = 0; ai < 2; ++ai)
#pragma unroll
            for (int m = 0; m < 4; ++m) { const size_t row = (size_t)(row0 + ai * HALF + m * 16); float q = 0.f;
#pragma unroll
                for (int bj = 0; bj < 2; ++bj) { const f32x4 a = acc[ai][bj][m][0], b = acc[ai][bj][m][1];
                    q += (a[0] * a[0] + a[1] * a[1]) + (a[2] * a[2] + a[3] * a[3]) + (b[0] * b[0] + b[1] * b[1]) + (b[2] * b[2] + b[3] * b[3]);
                    *(u32x4*)(O + row * 1024 + col0 + bj * HALF) = pack8(a, b); }
                q += __shfl_xor(q, 16); q += __shfl_xor(q, 32);
                if (fq == 0) RSS[row * 16 + u.pn * 4 + wc] = q; }
    }
};
template <class Epi, class Sched, bool ALIGN_EPI = false, bool SP2 = false>
__device__ __forceinline__ void gemm_phase(PG8_LAS unsigned char* lds, const Gemm g, const Sched& S, const Epi& E) {
    int tid_ = threadIdx.x; asm volatile("" : "+v"(tid_));
    const int tid = tid_, wid = __builtin_amdgcn_readfirstlane(tid >> 6), lane = tid & 63, wr = wid >> 2, wc = wid & 3, fr = lane & 15, fq = lane >> 4;
    const int K = g.K, nt = K / BK;
    unsigned voffA[2], voffB[2];
#pragma unroll
    for (int i = 0; i < 2; ++i) { int R, C; stage_rc(tid * 16 + i * 8192, R, C); const int Rb = Epi::PERM ? ((R & ~31) + perm32(R & 31)) : R;
        voffA[i] = (unsigned)(R * K + C) * 2u; voffB[i] = (unsigned)(Rb * K + C) * 2u; }
    const size_t kstep = (size_t)(BK * 2);
    const size_t hstep = (size_t)HALF * K * 2;
    const size_t tstep = 2 * hstep;
    const unsigned ldsw = (unsigned)wid * 1024u;
    const int aoff = lds_byte(wr * 64 + fr, fq * 8), boff = lds_byte(wc * 32 + fr, fq * 8);
#define PG8_SA(b, h) (((b) * 2 + (h)) * HTB)
#define PG8_SB(b, h) ((4 + (b) * 2 + (h)) * HTB)
#define PG8_STAGE(bufoff, gbase, voff) do { _Pragma("unroll") for (int _i = 0; _i < 2; ++_i) \
        __builtin_amdgcn_global_load_lds((const unsigned*)((const char*)(gbase) + (voff)[_i]), (PG8_LAS unsigned*)(lds + (bufoff) + ldsw + _i * 8192), 16, 0, 0); } while (0)
#define PG8_LDA(dst, b, h) do { _Pragma("unroll") for (int m = 0; m < 4; ++m) _Pragma("unroll") for (int k = 0; k < 2; ++k) dst[m][k] = *(const PG8_LAS bf16x8*)(lds + PG8_SA(b, h) + aoff + m * 2048 + k * 1024); } while (0)
#define PG8_LDB(dst, b, h) do { _Pragma("unroll") for (int n = 0; n < 2; ++n) _Pragma("unroll") for (int k = 0; k < 2; ++k) dst[n][k] = *(const PG8_LAS bf16x8*)(lds + PG8_SB(b, h) + boff + n * 2048 + k * 1024); } while (0)
#define PG8_MMA(ai, bj, At, Bt) do { __builtin_amdgcn_s_setprio(1); _Pragma("unroll") for (int m = 0; m < 4; ++m) _Pragma("unroll") for (int n = 0; n < 2; ++n) _Pragma("unroll") for (int k = 0; k < 2; ++k) \
        acc[ai][bj][m][n] = __builtin_amdgcn_mfma_f32_16x16x32_bf16(Bt[n][k], At[m][k], acc[ai][bj][m][n], 0, 0, 0); __builtin_amdgcn_s_setprio(0); } while (0)
#define PG8_WAIT_V(n) asm volatile("s_waitcnt vmcnt(" #n ")" ::: "memory")
#define PG8_WAIT_L(n) asm volatile("s_waitcnt lgkmcnt(" #n ")" ::: "memory")
#define PG8_BAR __builtin_amdgcn_s_barrier()
#define PG8_SCHED __builtin_amdgcn_sched_barrier(0)
    Unit cur, nxt; int ui = 0;
    if (!S.next(0, cur)) return;
    f32x4 acc[2][2][4][2];
#pragma unroll
    for (int a = 0; a < 2; ++a)
#pragma unroll
        for (int b = 0; b < 2; ++b)
#pragma unroll
            for (int m = 0; m < 4; ++m)
#pragma unroll
                for (int n = 0; n < 2; ++n) acc[a][b][m][n] = (f32x4){0.f, 0.f, 0.f, 0.f};
    bf16x8 At[4][2], B0[2][2], B1[2][2];
    const char* cA = (const char*)g.A + (size_t)cur.pm * tstep; const char* cB = (const char*)g.Bt + (size_t)cur.pn * tstep;
    S.a_ready(cur);
    if constexpr (SP2) {
        PG8_STAGE(PG8_SB(0, 0), cB, voffB); PG8_STAGE(PG8_SB(0, 1), cB + hstep, voffB); PG8_STAGE(PG8_SA(0, 0), cA, voffA); PG8_STAGE(PG8_SA(0, 1), cA + hstep, voffA);
        if (wr == 1) PG8_BAR;
        PG8_WAIT_V(2); PG8_BAR;
        PG8_STAGE(PG8_SB(1, 0), cB + kstep, voffB); PG8_STAGE(PG8_SA(1, 0), cA + kstep, voffA); PG8_STAGE(PG8_SB(1, 1), cB + hstep + kstep, voffB);
        PG8_WAIT_V(6); PG8_BAR;
    } else {
        PG8_STAGE(PG8_SB(0, 0), cB, voffB); PG8_STAGE(PG8_SA(0, 0), cA, voffA); PG8_STAGE(PG8_SB(0, 1), cB + hstep, voffB); PG8_STAGE(PG8_SA(0, 1), cA + hstep, voffA);
        if (wr == 1) PG8_BAR;
        PG8_WAIT_V(4); PG8_BAR;
        PG8_STAGE(PG8_SB(1, 0), cB + kstep, voffB); PG8_STAGE(PG8_SA(1, 0), cA + kstep, voffA); PG8_STAGE(PG8_SB(1, 1), cB + hstep + kstep, voffB);
        PG8_WAIT_V(6); PG8_BAR;
    }
    for (;;) {
        const bool has_next = S.next(ui + 1, nxt);
        const char* nA = has_next ? (const char*)g.A + (size_t)nxt.pm * tstep : cA; const char* nB = has_next ? (const char*)g.Bt + (size_t)nxt.pn * tstep : cB;
        for (int t = 0; t < nt; t += 2) {
            if constexpr (Epi::MIDK) { if (t == (nt >> 1)) E.mid(acc, cur, wr, wc, fr, fq); }
            const bool last = (t == nt - 2);
            const char* a1 = cA + (size_t)(t + 1) * kstep;
            const char* a2 = last ? nA : cA + (size_t)(t + 2) * kstep; const char* b2 = last ? nB : cB + (size_t)(t + 2) * kstep;
            const char* a3 = a2 + kstep; const char* b3 = b2 + kstep;
            if (last && has_next) S.a_ready(nxt);
            if constexpr (SP2) {
            PG8_LDB(B0, 0, 0); PG8_LDB(B1, 0, 1); PG8_SCHED; PG8_LDA(At, 0, 0); PG8_STAGE(PG8_SA(1, 1), a1 + hstep, voffA);
            PG8_WAIT_V(8); PG8_WAIT_L(0); PG8_BAR; PG8_MMA(0, 0, At, B0); PG8_MMA(0, 1, At, B1); PG8_BAR; PG8_SCHED;
            PG8_LDA(At, 0, 1); PG8_STAGE(PG8_SB(0, 0), b2, voffB); PG8_STAGE(PG8_SB(0, 1), b2 + hstep, voffB); PG8_STAGE(PG8_SA(0, 0), a2, voffA);
            PG8_WAIT_V(8); PG8_WAIT_L(0); PG8_BAR; PG8_MMA(1, 0, At, B0); PG8_MMA(1, 1, At, B1); PG8_BAR; PG8_SCHED;
            PG8_LDB(B0, 1, 0); PG8_LDB(B1, 1, 1); PG8_SCHED; PG8_LDA(At, 1, 0); PG8_STAGE(PG8_SA(0, 1), a2 + hstep, voffA);
            PG8_WAIT_V(8); PG8_WAIT_L(0); PG8_BAR; PG8_MMA(0, 0, At, B0); PG8_MMA(0, 1, At, B1); PG8_BAR; PG8_SCHED;
            PG8_LDA(At, 1, 1); PG8_STAGE(PG8_SB(1, 0), b3, voffB); PG8_STAGE(PG8_SB(1, 1), b3 + hstep, voffB); PG8_STAGE(PG8_SA(1, 0), a3, voffA);
            PG8_WAIT_V(8); PG8_WAIT_L(0); PG8_BAR; PG8_MMA(1, 0, At, B0); PG8_MMA(1, 1, At, B1); PG8_BAR; PG8_SCHED;
            } else {
            PG8_LDB(B0, 0, 0); PG8_SCHED; PG8_LDA(At, 0, 0); PG8_STAGE(PG8_SA(1, 1), a1 + hstep, voffA);
            PG8_WAIT_L(8); PG8_BAR; PG8_WAIT_L(0); PG8_MMA(0, 0, At, B0); PG8_BAR; PG8_SCHED;
            PG8_LDB(B1, 0, 1); PG8_STAGE(PG8_SB(0, 0), b2, voffB);
            PG8_BAR; PG8_WAIT_L(0); PG8_MMA(0, 1, At, B1); PG8_BAR;
            PG8_LDA(At, 0, 1); PG8_STAGE(PG8_SA(0, 0), a2, voffA);
            PG8_BAR; PG8_WAIT_L(0); PG8_MMA(1, 0, At, B0); PG8_BAR; PG8_SCHED;
            PG8_STAGE(PG8_SB(0, 1), b2 + hstep, voffB);
            PG8_WAIT_V(6); PG8_BAR; PG8_MMA(1, 1, At, B1); PG8_BAR;
            PG8_LDB(B0, 1, 0); PG8_SCHED; PG8_LDA(At, 1, 0); PG8_STAGE(PG8_SA(0, 1), a2 + hstep, voffA);
            PG8_WAIT_L(8); PG8_BAR; PG8_WAIT_L(0); PG8_MMA(0, 0, At, B0); PG8_BAR; PG8_SCHED;
            PG8_LDB(B1, 1, 1); PG8_STAGE(PG8_SB(1, 0), b3, voffB);
            PG8_BAR; PG8_WAIT_L(0); PG8_MMA(0, 1, At, B1); PG8_BAR;
            PG8_LDA(At, 1, 1); PG8_STAGE(PG8_SA(1, 0), a3, voffA);
            PG8_BAR; PG8_WAIT_L(0); PG8_MMA(1, 0, At, B0); PG8_BAR; PG8_SCHED;
            PG8_STAGE(PG8_SB(1, 1), b3 + hstep, voffB);
            PG8_WAIT_V(6); PG8_BAR; PG8_MMA(1, 1, At, B1); PG8_BAR;
            }
        }
        if constexpr (ALIGN_EPI) { if (wr == 0) PG8_BAR; }
        if constexpr (!Epi::AFTER_DRAIN) { E(acc, cur, wr, wc, fr, fq); S.done(cur); }
        if (!has_next) break;
#pragma unroll
        for (int a = 0; a < 2; ++a)
#pragma unroll
            for (int b = 0; b < 2; ++b)
#pragma unroll
                for (int m = 0; m < 4; ++m)
#pragma unroll
                    for (int n = 0; n < 2; ++n) acc[a][b][m][n] = (f32x4){0.f, 0.f, 0.f, 0.f};
        cur = nxt; cA = nA; cB = nB; ++ui;
        if constexpr (ALIGN_EPI) { if (wr == 1) PG8_BAR; }
    }
    PG8_WAIT_V(0);
    if constexpr (!ALIGN_EPI) { if (wr == 0) PG8_BAR; }
    PG8_BAR;
    if constexpr (Epi::AFTER_DRAIN) { E.fused(acc, cur, wr, wc, fr, fq, lds, wid, lane); S.done(cur); }
#undef PG8_SA
#undef PG8_SB
#undef PG8_STAGE
#undef PG8_LDA
#undef PG8_LDB
#undef PG8_MMA
#undef PG8_WAIT_V
#undef PG8_WAIT_L
#undef PG8_BAR
#undef PG8_SCHED
}
}
#define GAS __attribute__((address_space(1)))
#define LAS __attribute__((address_space(3)))
typedef unsigned short bf16;
typedef unsigned v4u __attribute__((ext_vector_type(4)));
typedef float f32x4 __attribute__((ext_vector_type(4)));
typedef short bf16x8 __attribute__((ext_vector_type(8)));
typedef GAS unsigned gu32;
typedef GAS unsigned long long gu64;
#define RLX_AGENT __ATOMIC_RELAXED, __HIP_MEMORY_SCOPE_AGENT
#define LDS_WAIT() asm volatile("s_waitcnt lgkmcnt(0)" ::: "memory")
#define VM_WAIT() asm volatile("s_waitcnt vmcnt(0)" ::: "memory")
__device__ __forceinline__ unsigned long long rt() { return __builtin_amdgcn_s_memrealtime(); }
__device__ __forceinline__ unsigned f2bf(float f) { unsigned u = __builtin_bit_cast(unsigned, f); return (u + 0x7fffu + ((u >> 16) & 1u)) >> 16; }
__device__ __forceinline__ unsigned pk2(float lo, float hi) { return f2bf(lo) | (f2bf(hi) << 16); }

#define XB_TMO      128
#define XB_XCNT(j)  (256  + 64 * (j))
#define XB_XSUB(j)  (1280 + 64 * (j))
#define XB_XGEN(j)  (2304 + 64 * (j))
#define XB_TOP      3328
#define XB_TOPGEN   3392
#define XCD_BAR_WORDS 3456
#define XB_SPIN_CAP (1u << 18)

__device__ __forceinline__ unsigned xb_ld(unsigned* p)              { return __hip_atomic_load(p, __ATOMIC_RELAXED, __HIP_MEMORY_SCOPE_AGENT); }
__device__ __forceinline__ unsigned xb_add(unsigned* p, unsigned v) { return __hip_atomic_fetch_add(p, v, __ATOMIC_RELAXED, __HIP_MEMORY_SCOPE_AGENT); }
__device__ __forceinline__ unsigned xb_xcc_id() { return (unsigned)__builtin_amdgcn_s_getreg((3 << 11) | 20) & 0xFu; }
#define XB_SPIN(cond, bar) do { unsigned _sp = 0; while (cond) { __builtin_amdgcn_s_sleep(1); \
    if ((++_sp & 255u) == 0u) { if (xb_ld(&(bar)[XB_TMO])) break; if (_sp > XB_SPIN_CAP) { atomicAdd(&(bar)[XB_TMO], 1u); break; } } } } while (0)

struct XcdBarrier {
    unsigned* bar; unsigned x;
    volatile LAS unsigned* st;
};

__device__ __forceinline__ XcdBarrier xcd_barrier_post(unsigned* bar, volatile LAS unsigned* st) {
    XcdBarrier b; b.bar = bar; b.x = xb_xcc_id(); b.st = st;
    if (threadIdx.x == 0) (void)xb_add(&bar[XB_XCNT(b.x)], 1u);
    return b;
}
__device__ __forceinline__ void xcd_barrier_complete(unsigned* bar, unsigned x, unsigned& nloc, unsigned& nx) {
    const unsigned G = gridDim.x * gridDim.y * gridDim.z;
    unsigned sum, cnt, mine, sp = 0u;
    for (;;) {
        sum = 0u; cnt = 0u; mine = 0u;
#pragma unroll
        for (unsigned j = 0; j < 16; ++j) { const unsigned c = xb_ld(&bar[XB_XCNT(j)]); sum += c; cnt += (c > 0u) ? 1u : 0u; mine = (j == x) ? c : mine; }
        if (sum == G) break;
        __builtin_amdgcn_s_sleep(1);
        if ((++sp & 255u) == 0u) { if (xb_ld(&bar[XB_TMO])) break; if (sp > XB_SPIN_CAP) { atomicAdd(&bar[XB_TMO], 1u); break; } }
    }
    nloc = mine > 0u ? mine : 1u; nx = cnt > 0u ? cnt : 1u;
}

__device__ __forceinline__ void xcd_barrier(const XcdBarrier& b) {
    asm volatile("s_waitcnt vmcnt(0)" ::: "memory");
    __syncthreads();
    if (threadIdx.x == 0) {
        unsigned* bar = b.bar;
        __builtin_amdgcn_s_waitcnt(0);
        unsigned nloc = b.st[0], nx = b.st[1];
        if (nloc == 0u) { xcd_barrier_complete(bar, b.x, nloc, nx); b.st[0] = nloc; b.st[1] = nx; }
        const unsigned old = xb_add(&bar[XB_XSUB(b.x)], 1u);
        const unsigned gen = old / nloc;
        if (old + 1u == (gen + 1u) * nloc) {
            __builtin_amdgcn_fence(__ATOMIC_RELEASE, "agent");
            asm volatile("s_waitcnt vmcnt(0)" ::: "memory");
            const unsigned og = xb_add(&bar[XB_TOP], 1u);
            const unsigned tg = og / nx;
            if (og + 1u == (tg + 1u) * nx) xb_add(&bar[XB_TOPGEN], 1u);
            else XB_SPIN(xb_ld(&bar[XB_TOPGEN]) == tg, bar);
            __builtin_amdgcn_fence(__ATOMIC_ACQUIRE, "agent");
            xb_add(&bar[XB_XGEN(b.x)], 1u);
            asm volatile("s_waitcnt vmcnt(0)" ::: "memory");
        } else {
            XB_SPIN(xb_ld(&bar[XB_XGEN(b.x)]) == gen, bar);
            __builtin_amdgcn_fence(__ATOMIC_ACQUIRE, "agent");
            asm volatile("s_waitcnt vmcnt(0)" ::: "memory");
        }
    }
    __syncthreads();
}

constexpr int NWAVES = 8;
constexpr int N_LAUNCHES = MK_N_LAUNCHES;
constexpr int PER_PHASE = 7;
constexpr int BATCH = 8, SEQ = 4096, DM = 1024, M = BATCH * SEQ;
constexpr int D_IN = 4864, NBLK = M / 128;
constexpr float EPS = 1e-6f;

constexpr size_t MiB = 1u << 20;
constexpr size_t WS_CTL = 0, CTL_ZERO_BYTES = 64 * 1024;
constexpr size_t WS_WIN = 2 * MiB;
constexpr size_t WS_WP = 12 * MiB;
constexpr size_t WS_WO = 14 * MiB;
constexpr size_t WS_WS = 16 * MiB;
constexpr size_t WS_ADA = 16 * MiB + 512 * 1024;
constexpr size_t WS_COS = 18 * MiB, WS_SIN = 22 * MiB;
constexpr size_t WS_RSS = 26 * MiB;
constexpr size_t WS_H = 32 * MiB;
constexpr size_t WS_QKV = 96 * MiB;
constexpr size_t WS_ZA = 144 * MiB;
constexpr size_t WS_UZ = 176 * MiB;
constexpr size_t WS_VG = 208 * MiB;
constexpr size_t WS_G = 240 * MiB;
constexpr size_t WS_MRG = 368 * MiB;
constexpr size_t WS_END = 432 * MiB;
constexpr int CW_BAR = 1024;

constexpr int RING_OFF = 0, RING_BYTES = 131072;
constexpr int LDSCTL_OFF = RING_BYTES, MISC_OFF = LDSCTL_OFF + 320;
constexpr int LDS_BYTES = 147456;

struct Frame {
    LAS unsigned char* lds;
    volatile LAS unsigned* MISC;
    gu32* ctl;
    int tid, lane, wave;
    int vcu, G;
    const float *x, *c, *w_ada, *b_ada, *g_pre, *g_post, *w_in, *sinks, *ln_g, *ln_b, *w_s, *b_s, *w_pa, *w_pb, *w_out;
    const int* pos;
    float* out;
    bf16 *WinT, *WpT, *WoT, *WsB, *H, *QKV, *ZA, *UZ, *VG, *GT, *MRG;
    float *ADA, *COS, *SIN, *RSS;
};

__device__ __forceinline__ float wave_sum(float v) {
#pragma unroll
    for (int o = 1; o < 64; o <<= 1) v += __shfl_xor(v, o);
    return v;
}
__device__ __forceinline__ float bfl(unsigned w) { return __uint_as_float(w << 16); }
__device__ __forceinline__ float bfh(unsigned w) { return __uint_as_float(w & 0xffff0000u); }
__device__ __forceinline__ float sigmf(float v) { return __builtin_amdgcn_rcpf(1.0f + __builtin_amdgcn_exp2f(-1.4426950408889634f * v)); }

__device__ __forceinline__ int proj_logical_col(int np) {
    const int pn = np >> 8, p = np & 255, bj = p >> 7, w = (p >> 5) & 3, dd = p & 31;
    if (pn < 2) return (4 * pn + w) * 64 + bj * 32 + dd;
    if (pn == 2) return w < 2 ? 512 + w * 64 + bj * 32 + dd : 640 + bj * 64 + (w - 2) * 32 + dd;
    if (pn < 5) return 768 + (pn - 3) * 256 + p;
    if (pn < 9) return (bj == 0 ? 1280 : 2304) + (pn - 5) * 128 + (p & 127);
    if (pn < 11) return 1792 + (pn - 9) * 256 + p;
    return 2816 + (pn - 11) * 256 + p;
}

__device__ __forceinline__ void p0_transpose_item(const float* W, int Nsrc, int k0, int csrc, bf16* WT, int ldk, int ndst, int kdst, LAS float* scr, int lane) {
#pragma unroll
    for (int i = 0; i < 32; ++i) { const int kk = 2 * i + (lane >> 5); scr[kk * 33 + (lane & 31)] = W[(size_t)(k0 + kk) * Nsrc + csrc + (lane & 31)]; }
    LDS_WAIT(); asm volatile("" ::: "memory");
    const int c = lane & 7;
#pragma unroll
    for (int j = 0; j < 4; ++j) { const int n = (lane >> 3) + 8 * j; const LAS float* s = scr + (8 * c) * 33 + n;
        v4u o; o.x = pk2(s[0 * 33], s[1 * 33]); o.y = pk2(s[2 * 33], s[3 * 33]); o.z = pk2(s[4 * 33], s[5 * 33]); o.w = pk2(s[6 * 33], s[7 * 33]);
        *(GAS v4u*)(WT + (size_t)(ndst + n) * ldk + kdst + 8 * c) = o; }
    LDS_WAIT(); asm volatile("" ::: "memory");
}

__device__ __forceinline__ void sincos_acc(float a, float& s, float& c) {
    const double x = (double)a;
    const double kd = rint(x * 0.63661977236758134);
    double r = fma(-kd, 1.5707963267948966, x); r = fma(-kd, 6.123233995736766e-17, r);
    const int q = ((int)kd) & 3;
    const double r2 = r * r;
    const double sp = r * (1.0 + r2 * (-1.0 / 6.0 + r2 * (1.0 / 120.0 + r2 * (-1.0 / 5040.0 + r2 * (1.0 / 362880.0 + r2 * (-1.0 / 39916800.0))))));
    const double cp = 1.0 + r2 * (-0.5 + r2 * (1.0 / 24.0 + r2 * (-1.0 / 720.0 + r2 * (1.0 / 40320.0 + r2 * (-1.0 / 3628800.0 + r2 * (1.0 / 479001600.0))))));
    const double ss = (q & 1) ? cp : sp, cc = (q & 1) ? sp : cp;
    s = (float)((q & 2) ? -ss : ss);
    c = (float)(((q + 1) & 2) ? -cc : cc);
}

__device__ __forceinline__ void p0_prologue(Frame& F, const float* invf  ) {
    const int gw = F.vcu * NWAVES + F.wave, NGW = F.G * NWAVES;
    {
        LAS float* cs = (LAS float*)(F.lds);
        LAS float* red = (LAS float*)(F.lds + 32768);
        for (int i = F.tid; i < BATCH * DM; i += NWAVES * 64) { const float v = F.c[i]; cs[i] = v * sigmf(v); }
        __syncthreads();
        for (int cb = F.vcu; cb < 256; cb += F.G) {
            const int j = F.tid % 12, kg = F.tid / 12;
            float a[BATCH];
#pragma unroll
            for (int b = 0; b < BATCH; ++b) a[b] = 0.f;
            if (kg < 42) { float w[25];
#pragma unroll
                for (int i = 0; i < 25; ++i) { const int k = kg + 42 * i; w[i] = k < DM ? F.w_ada[(size_t)k * 3072 + cb * 12 + j] : 0.f; }
#pragma unroll
                for (int i = 0; i < 25; ++i) { const int k = kg + 42 * i; if (k < DM) {
#pragma unroll
                    for (int b = 0; b < BATCH; ++b) a[b] += cs[b * DM + k] * w[i]; } } }
            if (kg < 42) {
#pragma unroll
                for (int b = 0; b < BATCH; ++b) red[(kg * 12 + j) * 8 + b] = a[b]; }
            __syncthreads();
            if (F.tid < 96) { const int jj = F.tid >> 3, b = F.tid & 7; float s = 0.f;
                for (int g = 0; g < 42; ++g) s += red[(g * 12 + jj) * 8 + b];
                F.ADA[b * 3072 + cb * 12 + jj] = s + F.b_ada[cb * 12 + jj]; }
            __syncthreads();
        }
    }
    {
        LAS float* scr = (LAS float*)(F.lds + RING_OFF + F.wave * 16384);
        constexpr int I_IN = 16 * (D_IN / 32), I_P = 8 * 32, I_O = 16 * 32;
        constexpr int NITEMS = I_IN + 2 * I_P + I_O;
        for (int it = gw; it < NITEMS; it += NGW) {
            int r = it;
            if (r < I_IN) { const int nb = r % (D_IN / 32), kb = r / (D_IN / 32); p0_transpose_item(F.w_in, D_IN, 64 * kb, proj_logical_col(32 * nb), F.WinT, 1024, 32 * nb, 64 * kb, scr, F.lane); continue; } r -= I_IN;
            if (r < I_P) { const int nb = r % 32, kb = r / 32; p0_transpose_item(F.w_pa, 1024, 64 * kb, 32 * nb, F.WpT, 1024, 32 * nb, 64 * kb, scr, F.lane); continue; } r -= I_P;
            if (r < I_P) { const int nb = r % 32, kb = r / 32; p0_transpose_item(F.w_pb, 1024, 64 * kb, 32 * nb, F.WpT, 1024, 32 * nb, 512 + 64 * kb, scr, F.lane); continue; } r -= I_P;
            { const int nb = r % 32, kb = r / 32; p0_transpose_item(F.w_out, 1024, 64 * kb, 32 * nb, F.WoT, 1024, 32 * nb, 64 * kb, scr, F.lane); }
        }
    }
    const int gt = F.vcu * (NWAVES * 64) + F.tid, NGT = F.G * NWAVES * 64;
    for (int i = gt; i < 4 * 128 * 128; i += NGT) { const int s = i & 127, t = (i >> 7) & 127; F.WsB[i] = (bf16)(s <= t ? f2bf(F.w_s[i]) : 0u); }
    for (int i = gt; i < M * 32; i += NGT) { const int tok = i >> 5, fi = i & 31; const float ang = (float)F.pos[tok] * invf[fi]; float s, c; sincos_acc(ang, s, c); F.COS[i] = c; F.SIN[i] = s; }
}

__device__ __forceinline__ void p1_prenorm(Frame& F) {
    const int gw = F.vcu * NWAVES + F.wave, NGW = F.G * NWAVES;
    for (int m0 = gw * 16; m0 < M; m0 += NGW * 16) {
        const int b = m0 / SEQ;
        f32x4 ca[4], cb[4];
#pragma unroll
        for (int j = 0; j < 4; ++j) { const int col = 4 * F.lane + 256 * j;
            ca[j] = *(const f32x4*)(F.g_pre + col) * (*(const f32x4*)(F.ADA + b * 3072 + 1024 + col) + 1.0f); cb[j] = *(const f32x4*)(F.ADA + b * 3072 + col); }
#pragma unroll 1
        for (int r0 = 0; r0 < 16; r0 += 4) {
            f32x4 v[4][4];
#pragma unroll
            for (int r = 0; r < 4; ++r) { const GAS f32x4* xr = (const GAS f32x4*)(F.x + (size_t)(m0 + r0 + r) * DM) + F.lane;
#pragma unroll
                for (int j = 0; j < 4; ++j) v[r][j] = __builtin_nontemporal_load(xr + 64 * j); }
#pragma unroll
            for (int r = 0; r < 4; ++r) { float s2 = 0.f;
#pragma unroll
                for (int j = 0; j < 4; ++j) s2 += (v[r][j].x * v[r][j].x + v[r][j].y * v[r][j].y) + (v[r][j].z * v[r][j].z + v[r][j].w * v[r][j].w);
                const float rstd = 1.f / sqrtf(wave_sum(s2) * (1.f / DM) + EPS);
                GAS unsigned long long* o8 = (GAS unsigned long long*)(F.H + (size_t)(m0 + r0 + r) * DM) + F.lane;
#pragma unroll
                for (int j = 0; j < 4; ++j) { const f32x4 h = v[r][j] * rstd * ca[j] + cb[j];
                    o8[64 * j] = (unsigned long long)pk2(h.x, h.y) | ((unsigned long long)pk2(h.z, h.w) << 32); } }
        }
    }
}

__device__ __forceinline__ void p6_postnorm(Frame& F) {
    const int gw = F.vcu * NWAVES + F.wave, NGW = F.G * NWAVES;
    for (int m0 = gw * 16; m0 < M; m0 += NGW * 16) {
        const int b = m0 / SEQ;
        f32x4 cg[4];
#pragma unroll
        for (int j = 0; j < 4; ++j) { const int col = 4 * F.lane + 256 * j; cg[j] = *(const f32x4*)(F.g_post + col) * *(const f32x4*)(F.ADA + b * 3072 + 2048 + col); }
#pragma unroll 1
        for (int r0 = 0; r0 < 16; r0 += 4) {
            f32x4 xv[4][4]; unsigned long long yw[4][4]; float part[4];
#pragma unroll
            for (int r = 0; r < 4; ++r) { const size_t m = (size_t)(m0 + r0 + r);
                part[r] = F.lane < 16 ? F.RSS[m * 16 + F.lane] : 0.f;
                const GAS f32x4* xr = (const GAS f32x4*)(F.x + m * DM) + F.lane; const GAS unsigned long long* yr = (const GAS unsigned long long*)(F.H + m * DM) + F.lane;
#pragma unroll
                for (int j = 0; j < 4; ++j) { xv[r][j] = __builtin_nontemporal_load(xr + 64 * j); yw[r][j] = yr[64 * j]; } }
#pragma unroll
            for (int r = 0; r < 4; ++r) { const float rstd = 1.f / sqrtf(wave_sum(part[r]) * (1.f / DM) + EPS);
                GAS f32x4* orow = (GAS f32x4*)(F.out + (size_t)(m0 + r0 + r) * DM) + F.lane;
#pragma unroll
                for (int j = 0; j < 4; ++j) { const unsigned long long w = yw[r][j];
                    const f32x4 y = (f32x4){bfl((unsigned)w), bfh((unsigned)w), bfl((unsigned)(w >> 32)), bfh((unsigned)(w >> 32))};
                    __builtin_nontemporal_store(xv[r][j] + cg[j] * (y * rstd), orow + 64 * j); } }
        }
    }
}

typedef float f32x16 __attribute__((ext_vector_type(16)));
typedef unsigned u32x2 __attribute__((ext_vector_type(2)));
typedef float f32x2_t __attribute__((ext_vector_type(2))); typedef __bf16 bf16x2_t __attribute__((ext_vector_type(2)));
__device__ __forceinline__ unsigned cvtpk(float lo, float hi) { f32x2_t v = {lo, hi}; bf16x2_t b = __builtin_convertvector(v, bf16x2_t); return __builtin_bit_cast(unsigned, b); }
constexpr int KS_PITCH = 144, VT_PITCH = 520, KS_BYTES = 256 * KS_PITCH, VT_OFF = KS_BYTES;
constexpr int VN_PITCH = 272, VN_BYTES = 128 * VN_PITCH, ST_OFF = 2 * VN_BYTES;

__device__ __forceinline__ void attn_block(Frame& F, int blk) {
    const int nb = blk & 31, base = blk * 128, lane = F.lane, q = lane & 31, h = lane >> 5;
    LAS unsigned char* Ks = F.lds; LAS unsigned char* Vt = F.lds + VT_OFF;
    for (int kvh = 0; kvh < 2; ++kvh) {
#pragma unroll
        for (int i = 0; i < 4; ++i) { const int id = F.tid + 512 * i, key = id >> 3, ch = id & 7; const bool ok = (nb > 0) || (key >= 128);
            const size_t row = (size_t)(base - 128 + key);
            v4u kv = (v4u){0u, 0u, 0u, 0u}, vv = (v4u){0u, 0u, 0u, 0u};
            if (ok) { kv = *(const GAS v4u*)(F.QKV + row * 768 + 512 + kvh * 64 + ch * 8); vv = *(const GAS v4u*)(F.QKV + row * 768 + 640 + kvh * 64 + ch * 8); }
            *(LAS v4u*)(Ks + key * KS_PITCH + ch * 16) = kv;
            LAS unsigned short* vp = (LAS unsigned short*)(Vt + (ch * 8) * VT_PITCH + key * 2);
            vp[0 * (VT_PITCH / 2)] = (unsigned short)(vv.x & 0xffffu); vp[1 * (VT_PITCH / 2)] = (unsigned short)(vv.x >> 16);
            vp[2 * (VT_PITCH / 2)] = (unsigned short)(vv.y & 0xffffu); vp[3 * (VT_PITCH / 2)] = (unsigned short)(vv.y >> 16);
            vp[4 * (VT_PITCH / 2)] = (unsigned short)(vv.z & 0xffffu); vp[5 * (VT_PITCH / 2)] = (unsigned short)(vv.z >> 16);
            vp[6 * (VT_PITCH / 2)] = (unsigned short)(vv.w & 0xffffu); vp[7 * (VT_PITCH / 2)] = (unsigned short)(vv.w >> 16); }
        __syncthreads();
        const int g = F.wave >> 1, hq = kvh * 4 + g;
        const float sink2 = F.sinks[hq] * 1.4426950408889634f;
#pragma unroll 1
        for (int t = 0; t < 2; ++t) {
            const int qi = 2 * (F.wave & 1) + t; const size_t row = (size_t)(base + 32 * qi + q);
            bf16x8 qf[4];
#pragma unroll
            for (int ks = 0; ks < 4; ++ks) qf[ks] = *(const GAS bf16x8*)(F.QKV + row * 768 + hq * 64 + 16 * ks + 8 * h);
            f32x16 S[5];
#pragma unroll
            for (int kt = 0; kt < 5; ++kt) {
                f32x16 a = (f32x16){0.f, 0.f, 0.f, 0.f, 0.f, 0.f, 0.f, 0.f, 0.f, 0.f, 0.f, 0.f, 0.f, 0.f, 0.f, 0.f};
#pragma unroll
                for (int ks = 0; ks < 4; ++ks) { const bf16x8 kf = *(const LAS bf16x8*)(Ks + (32 * (qi + kt) + q) * KS_PITCH + (16 * ks + 8 * h) * 2);
                    a = __builtin_amdgcn_mfma_f32_32x32x16_bf16(kf, qf[ks], a, 0, 0, 0); }
                S[kt] = a; }
            float mx = sink2;
#pragma unroll
            for (int kt = 0; kt < 5; ++kt) { const bool tile_ok = (nb > 0) || (qi + kt >= 4);
#pragma unroll
                for (int r = 0; r < 16; ++r) { const int krow = (r & 3) + 8 * (r >> 2) + 4 * h; const int jrel = 32 * kt + krow - q;
                    const bool ok = tile_ok && (jrel > 0) && (jrel <= 128);
                    S[kt][r] = ok ? S[kt][r] : -INFINITY; mx = fmaxf(mx, S[kt][r]); } }
            mx = fmaxf(mx, __shfl_xor(mx, 32));
            float ls = 0.f;
#pragma unroll
            for (int kt = 0; kt < 5; ++kt)
#pragma unroll
                for (int r = 0; r < 16; ++r) { const float p = __builtin_amdgcn_exp2f(S[kt][r] - mx); S[kt][r] = p; ls += p; }
            ls += __shfl_xor(ls, 32);
            const float rl = 1.0f / (ls + __builtin_amdgcn_exp2f(sink2 - mx));
            f32x16 O[2];
#pragma unroll
            for (int dt = 0; dt < 2; ++dt) O[dt] = (f32x16){0.f, 0.f, 0.f, 0.f, 0.f, 0.f, 0.f, 0.f, 0.f, 0.f, 0.f, 0.f, 0.f, 0.f, 0.f, 0.f};
#pragma unroll
            for (int kt = 0; kt < 5; ++kt)
#pragma unroll
                for (int s = 0; s < 2; ++s) {
                    v4u pw; pw.x = cvtpk(S[kt][8 * s + 0], S[kt][8 * s + 1]); pw.y = cvtpk(S[kt][8 * s + 2], S[kt][8 * s + 3]); pw.z = cvtpk(S[kt][8 * s + 4], S[kt][8 * s + 5]); pw.w = cvtpk(S[kt][8 * s + 6], S[kt][8 * s + 7]);
                    const bf16x8 pf = __builtin_bit_cast(bf16x8, pw);
#pragma unroll
                    for (int dt = 0; dt < 2; ++dt) { const LAS unsigned char* vp = Vt + (32 * dt + q) * VT_PITCH + (32 * (qi + kt) + 16 * s + 4 * h) * 2;
                        const u32x2 lo = *(const LAS u32x2*)vp, hi = *(const LAS u32x2*)(vp + 16);
                        const v4u vw = (v4u){lo.x, lo.y, hi.x, hi.y};
                        O[dt] = __builtin_amdgcn_mfma_f32_32x32x16_bf16(__builtin_bit_cast(bf16x8, vw), pf, O[dt], 0, 0, 0); } }
#pragma unroll
            for (int dt = 0; dt < 2; ++dt)
#pragma unroll
                for (int r4 = 0; r4 < 4; ++r4) { const int d0 = 32 * dt + 8 * r4 + 4 * h;
                    const u32x2 zw = *(const GAS u32x2*)(F.ZA + row * 512 + hq * 64 + d0);
                    u32x2 ow; ow.x = cvtpk(O[dt][4 * r4 + 0] * rl * bfl(zw.x), O[dt][4 * r4 + 1] * rl * bfh(zw.x)); ow.y = cvtpk(O[dt][4 * r4 + 2] * rl * bfl(zw.y), O[dt][4 * r4 + 3] * rl * bfh(zw.y));
                    *(GAS u32x2*)(F.H + row * 1024 + hq * 64 + d0) = ow; }
        }
        __syncthreads();
    }
}

__device__ __forceinline__ void gmlp_block(Frame& F, int blk) {
    const int base = blk * 128, lane = F.lane;
    LAS float* ST = (LAS float*)(F.lds + ST_OFF);
#pragma unroll 4
    for (int i = 0; i < 16; ++i) { const int tk = 16 * F.wave + i;
        const v4u w = *(const GAS v4u*)(F.VG + (size_t)(base + tk) * 512 + 8 * lane);
        const float v0 = bfl(w.x), v1 = bfh(w.x), v2 = bfl(w.y), v3 = bfh(w.y), v4 = bfl(w.z), v5 = bfh(w.z), v6 = bfl(w.w), v7 = bfh(w.w);
        const float mean = wave_sum(((v0 + v1) + (v2 + v3)) + ((v4 + v5) + (v6 + v7))) * (1.f / 512.f);
        const float d0 = v0 - mean, d1 = v1 - mean, d2 = v2 - mean, d3 = v3 - mean, d4 = v4 - mean, d5 = v5 - mean, d6 = v6 - mean, d7 = v7 - mean;
        const float var = wave_sum(((d0 * d0 + d1 * d1) + (d2 * d2 + d3 * d3)) + ((d4 * d4 + d5 * d5) + (d6 * d6 + d7 * d7))) * (1.f / 512.f);
        if (lane == 0) { ST[2 * tk] = mean; ST[2 * tk + 1] = 1.f / sqrtf(var + EPS); } }
    __syncthreads();
#pragma unroll 1
    for (int gp = 0; gp < 2; ++gp) {
        { const int g2 = F.tid >> 8, co = (F.tid >> 4) & 15, so = F.tid & 15, ch0 = (2 * gp + g2) * 128 + 8 * co;
            const f32x4 ga = *(const f32x4*)(F.ln_g + ch0), gb = *(const f32x4*)(F.ln_g + ch0 + 4), ba = *(const f32x4*)(F.ln_b + ch0), bb = *(const f32x4*)(F.ln_b + ch0 + 4);
            float vn[8][8];
#pragma unroll
            for (int i = 0; i < 8; ++i) { const int tk = 8 * so + i; const v4u w = *(const GAS v4u*)(F.VG + (size_t)(base + tk) * 512 + ch0);
                const float mean = ST[2 * tk], rstd = ST[2 * tk + 1];
                vn[i][0] = (bfl(w.x) - mean) * rstd * ga[0] + ba[0]; vn[i][1] = (bfh(w.x) - mean) * rstd * ga[1] + ba[1]; vn[i][2] = (bfl(w.y) - mean) * rstd * ga[2] + ba[2]; vn[i][3] = (bfh(w.y) - mean) * rstd * ga[3] + ba[3];
                vn[i][4] = (bfl(w.z) - mean) * rstd * gb[0] + bb[0]; vn[i][5] = (bfh(w.z) - mean) * rstd * gb[1] + bb[1]; vn[i][6] = (bfl(w.w) - mean) * rstd * gb[2] + bb[2]; vn[i][7] = (bfh(w.w) - mean) * rstd * gb[3] + bb[3]; }
            LAS unsigned char* dst = F.lds + g2 * VN_BYTES + (8 * co) * VN_PITCH + so * 16;
#pragma unroll
            for (int cc = 0; cc < 8; ++cc) { v4u o; o.x = cvtpk(vn[0][cc], vn[1][cc]); o.y = cvtpk(vn[2][cc], vn[3][cc]); o.z = cvtpk(vn[4][cc], vn[5][cc]); o.w = cvtpk(vn[6][cc], vn[7][cc]);
                *(LAS v4u*)(dst + cc * VN_PITCH) = o; } }
        __syncthreads();
        { const int g2 = F.wave >> 2, cj = F.wave & 3, g = 2 * gp + g2, t = lane & 31, h = lane >> 5;
            f32x16 acc[4];
#pragma unroll
            for (int ti = 0; ti < 4; ++ti) acc[ti] = (f32x16){0.f, 0.f, 0.f, 0.f, 0.f, 0.f, 0.f, 0.f, 0.f, 0.f, 0.f, 0.f, 0.f, 0.f, 0.f, 0.f};
            const LAS unsigned char* ap = F.lds + g2 * VN_BYTES + (32 * cj + t) * VN_PITCH + 16 * h;
            const bf16* wp = F.WsB + (size_t)g * 16384 + (size_t)t * 128 + 8 * h;
#pragma unroll
            for (int ks = 0; ks < 8; ++ks) { const bf16x8 af = *(const LAS bf16x8*)(ap + 32 * ks);
#pragma unroll
                for (int ti = 0; ti < 4; ++ti) if (2 * (ti + 1) > ks) { const bf16x8 bfr = *(const GAS bf16x8*)(wp + (size_t)ti * 4096 + 16 * ks);
                    acc[ti] = __builtin_amdgcn_mfma_f32_32x32x16_bf16(af, bfr, acc[ti], 0, 0, 0); } }
#pragma unroll
            for (int ti = 0; ti < 4; ++ti) { const int tk = 32 * ti + t; const float bs = F.b_s[g * 128 + tk]; const size_t row = (size_t)(base + tk);
#pragma unroll
                for (int r4 = 0; r4 < 4; ++r4) { const int c0 = g * 128 + 32 * cj + 8 * r4 + 4 * h;
                    const u32x2 uw = *(const GAS u32x2*)(F.UZ + row * 512 + c0);
                    u32x2 ow; ow.x = cvtpk((acc[ti][4 * r4 + 0] + bs) * bfl(uw.x), (acc[ti][4 * r4 + 1] + bs) * bfh(uw.x)); ow.y = cvtpk((acc[ti][4 * r4 + 2] + bs) * bfl(uw.y), (acc[ti][4 * r4 + 3] + bs) * bfh(uw.y));
                    *(GAS u32x2*)(F.H + row * 1024 + 512 + c0) = ow; } } }
        __syncthreads();
    }
}

__device__ __forceinline__ void naive_mixers(Frame& F, int blk) {
    const int nb = blk & 31, base = blk * 128, lane = F.lane;
    for (int it = F.wave; it < 128 * 8; it += NWAVES) { const int i = it >> 3, hq = it & 7, kvh = hq >> 2; const size_t row = (size_t)(base + i);
        const float qd = bfl((unsigned)F.QKV[row * 768 + hq * 64 + lane]);
        const float sink2 = F.sinks[hq] * 1.4426950408889634f;
        float m = sink2, l = 1.0f, o = 0.f;
        int j0 = i - 127; if (nb == 0 && j0 < 0) j0 = 0;
        for (int j = j0; j <= i; ++j) { const size_t kr = (size_t)(base + j);
            const float s = wave_sum(qd * bfl((unsigned)F.QKV[kr * 768 + 512 + kvh * 64 + lane]));
            const float mn = fmaxf(m, s), sc = exp2f(m - mn), p = exp2f(s - mn);
            l = l * sc + p; o = o * sc + p * bfl((unsigned)F.QKV[kr * 768 + 640 + kvh * 64 + lane]); m = mn; }
        const float y = o / l * bfl((unsigned)F.ZA[row * 512 + hq * 64 + lane]);
        F.H[row * 1024 + hq * 64 + lane] = (bf16)f2bf(y); }
    LAS float* ST = (LAS float*)(F.lds);
    __syncthreads();
    if (F.tid < 128) { const size_t row = (size_t)(base + F.tid); float s = 0.f; for (int c = 0; c < 512; ++c) s += bfl((unsigned)F.VG[row * 512 + c]);
        const float mean = s / 512.f; float q = 0.f; for (int c = 0; c < 512; ++c) { const float dlt = bfl((unsigned)F.VG[row * 512 + c]) - mean; q += dlt * dlt; }
        ST[2 * F.tid] = mean; ST[2 * F.tid + 1] = 1.f / sqrtf(q / 512.f + EPS); }
    __syncthreads();
    for (int it = F.tid; it < 128 * 512; it += NWAVES * 64) { const int t = it >> 9, ch = it & 511, g = ch >> 7; float acc = 0.f;
        for (int s = 0; s <= t; ++s) { const float vn = (bfl((unsigned)F.VG[(size_t)(base + s) * 512 + ch]) - ST[2 * s]) * ST[2 * s + 1] * F.ln_g[ch] + F.ln_b[ch];
            acc += F.w_s[(g * 128 + t) * 128 + s] * vn; }
        const float y = (acc + F.b_s[g * 128 + t]) * bfl((unsigned)F.UZ[(size_t)(base + t) * 512 + ch]);
        F.H[(size_t)(base + t) * 1024 + 512 + ch] = (bf16)f2bf(y); }
    __syncthreads();
}

__device__ __forceinline__ float naive_dot_in(Frame& F, size_t row, int c) { float a = 0.f; for (int k = 0; k < DM; ++k) a += bfl((unsigned)F.H[row * 1024 + k]) * F.w_in[(size_t)k * D_IN + c]; return a; }
__device__ __forceinline__ float gelu_exact(float v) { return 0.5f * v * (1.0f + erff(v * 0.70710678118654752f)); }
__device__ __forceinline__ void naive_proj(Frame& F) {
    const size_t gt = (size_t)F.vcu * (NWAVES * 64) + F.tid, NGT = (size_t)F.G * NWAVES * 64;
    for (size_t it = gt; it < (size_t)M * 4352; it += NGT) { const size_t row = it / 4352; const int j = (int)(it % 4352);
        if (j < 640) { const int d = j & 63, dd = d & 31; const int c1 = (j & ~63) + dd, c2 = c1 + 32;
            const float t1 = naive_dot_in(F, row, c1), t2 = naive_dot_in(F, row, c2), cs = F.COS[row * 32 + dd], sn = F.SIN[row * 32 + dd];
            float o = d < 32 ? t1 * cs - t2 * sn : t2 * cs + t1 * sn; if (j < 512) o *= 0.125f * 1.4426950408889634f;
            F.QKV[row * 768 + j] = (bf16)f2bf(o); }
        else if (j < 768) F.QKV[row * 768 + j] = (bf16)f2bf(naive_dot_in(F, row, j));
        else if (j < 1280) { const float v = naive_dot_in(F, row, j); F.ZA[row * 512 + (j - 768)] = (bf16)f2bf(v * sigmf(v)); }
        else if (j < 1792) { const float u = naive_dot_in(F, row, j), z = naive_dot_in(F, row, j + 1024); F.UZ[row * 512 + (j - 1280)] = (bf16)f2bf(gelu_exact(u) * z * sigmf(z)); }
        else if (j < 2304) { const float v = naive_dot_in(F, row, j); F.VG[row * 512 + (j - 1792)] = (bf16)f2bf(gelu_exact(v)); }
        else { const float v = naive_dot_in(F, row, j + 512); F.GT[row * 2048 + (j - 2304)] = (bf16)f2bf(sigmf(v)); } }
}
__device__ __forceinline__ void naive_merge(Frame& F) {
    const size_t gt = (size_t)F.vcu * (NWAVES * 64) + F.tid, NGT = (size_t)F.G * NWAVES * 64;
    for (size_t it = gt; it < (size_t)M * DM; it += NGT) { const size_t row = it >> 10; const int n = (int)(it & 1023); float a = 0.f, b = 0.f;
        for (int k = 0; k < 512; ++k) { a += bfl((unsigned)F.H[row * 1024 + k]) * F.w_pa[(size_t)k * 1024 + n]; b += bfl((unsigned)F.H[row * 1024 + 512 + k]) * F.w_pb[(size_t)k * 1024 + n]; }
        F.MRG[it] = (bf16)f2bf(bfl((unsigned)F.GT[row * 2048 + n]) * a + bfl((unsigned)F.GT[row * 2048 + 1024 + n]) * b); }
}
__device__ __forceinline__ void naive_out(Frame& F) {
    LAS float* red = (LAS float*)F.lds;
    for (int row = F.vcu; row < M; row += F.G) { float q = 0.f;
        for (int n = F.tid; n < DM; n += NWAVES * 64) { float a = 0.f; for (int k = 0; k < DM; ++k) a += bfl((unsigned)F.MRG[(size_t)row * 1024 + k]) * F.w_out[(size_t)k * 1024 + n];
            F.H[(size_t)row * 1024 + n] = (bf16)f2bf(a); q += a * a; }
        q = wave_sum(q); if (F.lane == 0) red[F.wave] = q; __syncthreads();
        if (F.tid < 16) F.RSS[(size_t)row * 16 + F.tid] = F.tid == 0 ? ((red[0] + red[1]) + (red[2] + red[3])) + ((red[4] + red[5]) + (red[6] + red[7])) : 0.f;
        __syncthreads(); }
}

struct Args { const void* in[16]; float* out; unsigned char* ws; float invf[32]; int ph_lo, ph_hi, li, pad; };

typedef const __attribute__((address_space(4))) Args* KArgs;
__device__ __forceinline__ void fresh_tid(Frame& F) { int t = threadIdx.x; asm volatile("" : "+v"(t)); F.tid = t; F.lane = t & 63; }
__device__ __forceinline__ KArgs fresh_args() { KArgs p = (KArgs)__builtin_amdgcn_kernarg_segment_ptr(); asm volatile("" : "+s"(p)); return p; }
__device__ __forceinline__ void fill_frame(Frame& F, KArgs a) {
    unsigned char* ws = a->ws;
    F.x = (const float*)a->in[0]; F.c = (const float*)a->in[1]; F.pos = (const int*)a->in[2]; F.w_ada = (const float*)a->in[3]; F.b_ada = (const float*)a->in[4];
    F.g_pre = (const float*)a->in[5]; F.g_post = (const float*)a->in[6]; F.w_in = (const float*)a->in[7]; F.sinks = (const float*)a->in[8];
    F.ln_g = (const float*)a->in[9]; F.ln_b = (const float*)a->in[10]; F.w_s = (const float*)a->in[11]; F.b_s = (const float*)a->in[12];
    F.w_pa = (const float*)a->in[13]; F.w_pb = (const float*)a->in[14]; F.w_out = (const float*)a->in[15]; F.out = a->out;
    F.WinT = (bf16*)(ws + WS_WIN); F.WpT = (bf16*)(ws + WS_WP); F.WoT = (bf16*)(ws + WS_WO); F.WsB = (bf16*)(ws + WS_WS);
    F.H = (bf16*)(ws + WS_H); F.QKV = (bf16*)(ws + WS_QKV); F.ZA = (bf16*)(ws + WS_ZA); F.UZ = (bf16*)(ws + WS_UZ); F.VG = (bf16*)(ws + WS_VG); F.GT = (bf16*)(ws + WS_G); F.MRG = (bf16*)(ws + WS_MRG);
    F.ADA = (float*)(ws + WS_ADA); F.COS = (float*)(ws + WS_COS); F.SIN = (float*)(ws + WS_SIN); F.RSS = (float*)(ws + WS_RSS);
}

#ifndef DBG_STOP
#define DBG_STOP -1
#endif
__device__ __forceinline__ float bf2f(bf16 v) { return __uint_as_float((unsigned)v << 16); }
__device__ __forceinline__ void dbg_dump(Frame& F) {
    const size_t gt = (size_t)F.vcu * (NWAVES * 64) + F.tid, NGT = (size_t)F.G * NWAVES * 64, NOUT = (size_t)M * DM;
    for (size_t i = gt; i < NOUT; i += NGT) {
        float v = 0.f;
        if (DBG_STOP == 0) v = bf2f(F.WinT[i % ((size_t)D_IN * 1024)]) + bf2f(F.WpT[i % (1024 * 1024)]) + bf2f(F.WoT[i % (1024 * 1024)]) + bf2f(F.WsB[i % 65536]) + F.ADA[i % 24576] + F.COS[i % ((size_t)M * 32)] + F.SIN[i % ((size_t)M * 32)];
        if (DBG_STOP == 1 || DBG_STOP == 3) v = bf2f(F.H[i]);
        if (DBG_STOP == 2) v = bf2f(F.GT[2 * i]) + 2.f * bf2f(F.GT[2 * i + 1]) + bf2f(F.QKV[i % ((size_t)M * 768)]) + bf2f(F.ZA[i % ((size_t)M * 512)]) + bf2f(F.UZ[i % ((size_t)M * 512)]) + bf2f(F.VG[i % ((size_t)M * 512)]);
        if (DBG_STOP == 4) v = bf2f(F.MRG[i]);
        if (DBG_STOP == 5) v = bf2f(F.H[i]) + F.RSS[i % ((size_t)M * 16)];
        F.out[i] = v;
    }
}
__global__ void __launch_bounds__(NWAVES * 64, 2) hybrid_fwd(Args args) {
    extern __shared__ __attribute__((aligned(16))) unsigned char lds[];
    Frame F;
    F.lds = (LAS unsigned char*)lds;
    F.MISC = (volatile LAS unsigned*)(F.lds + MISC_OFF);
    F.tid = threadIdx.x; F.lane = F.tid & 63; F.wave = __builtin_amdgcn_readfirstlane(F.tid >> 6);
    F.G = gridDim.x; { const int bx = blockIdx.x; F.vcu = (F.G % 8 == 0) ? (bx % 8) * (F.G / 8) + bx / 8 : bx; }
    F.ctl = (gu32*)(args.ws + WS_CTL);
    for (int u = F.tid; u < (LDS_BYTES - LDSCTL_OFF) / 4; u += NWAVES * 64) ((LAS unsigned*)(F.lds + LDSCTL_OFF))[u] = 0u;
    __syncthreads();
    if (F.tid < 32) ((LAS float*)(F.lds + LDSCTL_OFF + 1024))[F.tid] = args.invf[F.tid];
    __syncthreads();
    XcdBarrier bar; bar.bar = (unsigned*)(F.ctl + CW_BAR); bar.x = 0; bar.st = nullptr;
    if (N_LAUNCHES != PER_PHASE) bar = xcd_barrier_post((unsigned*)(F.ctl + CW_BAR), F.MISC + 8);
#define GRID_BAR() do { if (N_LAUNCHES != PER_PHASE) xcd_barrier(bar); } while (0)
#if defined(DBG_TS)
    volatile LAS unsigned long long* TS = (volatile LAS unsigned long long*)(F.lds + LDSCTL_OFF + 2048);
#define STAMP(k) do { if (blockIdx.x == 0 && threadIdx.x == 0) TS[k] = __builtin_amdgcn_s_memrealtime(); } while (0)
#else
#define STAMP(k) do { } while (0)
#endif
    STAMP(0);
    const int lo = args.ph_lo, hi = args.ph_hi;
#define IN(k) (lo <= (k) && (k) < hi)
#define BOTH(k) (IN(k) && IN((k) + 1))
    if (IN(0)) { fill_frame(F, fresh_args()); fresh_tid(F); p0_prologue(F, (const float*)(lds + LDSCTL_OFF + 1024)); if (BOTH(0)) GRID_BAR(); STAMP(1); }
    if (IN(1)) { fill_frame(F, fresh_args()); fresh_tid(F); p1_prenorm(F); if (BOTH(1)) GRID_BAR(); STAMP(2); }
    if (IN(2)) { fill_frame(F, fresh_args()); fresh_tid(F);
#if defined(NAIVE_P2)
        naive_proj(F);
#endif
#if defined(DBG_TILEMASK)
        GRID_BAR();
#endif
#if !defined(NAIVE_P2) || defined(DBG_TILEMASK)
        pg8::Gemm g{F.H, F.WinT, M, D_IN, DM}; pg8::StaticOrder S; S.init(M, D_IN, F.G, (int)blockIdx.x);
        pg8::EpiProj E{F.QKV, F.ZA, F.UZ, F.VG, F.GT, F.COS, F.SIN};
        pg8::gemm_phase<pg8::EpiProj, pg8::StaticOrder, true, true>(F.lds + RING_OFF, g, S, E);
#endif
        if (BOTH(2)) GRID_BAR(); STAMP(3);
    }
    if (IN(3)) { fill_frame(F, fresh_args()); fresh_tid(F);
#if defined(NAIVE_P3)
        for (int blk = F.vcu; blk < NBLK; blk += F.G) naive_mixers(F, blk);
#else
        for (int blk = F.vcu; blk < NBLK; blk += F.G) { attn_block(F, blk); gmlp_block(F, blk); }
#endif
        if (BOTH(3)) GRID_BAR(); STAMP(4);
    }
    if (IN(4)) { fill_frame(F, fresh_args()); fresh_tid(F);
#if defined(NAIVE_P45)
        naive_merge(F);
#else
        pg8::Gemm g{F.H, F.WpT, M, DM, DM}; pg8::StaticOrder S; S.init(M, DM, F.G, (int)blockIdx.x);
        pg8::EpiMerge E{F.GT, F.MRG};
        pg8::gemm_phase<pg8::EpiMerge, pg8::StaticOrder, true, true>(F.lds + RING_OFF, g, S, E);
#endif
        if (BOTH(4)) GRID_BAR(); STAMP(5);
    }
    if (IN(5)) { fill_frame(F, fresh_args()); fresh_tid(F);
#if defined(NAIVE_P45)
        naive_out(F);
#else
        pg8::Gemm g{F.MRG, F.WoT, M, DM, DM}; pg8::StaticOrder S; S.init(M, DM, F.G, (int)blockIdx.x);
        pg8::EpiY E{F.H, F.RSS};
        pg8::gemm_phase<pg8::EpiY, pg8::StaticOrder, true, true>(F.lds + RING_OFF, g, S, E);
#endif
        if (BOTH(5)) GRID_BAR(); STAMP(6);
    }
    if (IN(6)) { fill_frame(F, fresh_args()); fresh_tid(F); if (DBG_STOP >= 0) dbg_dump(F); else p6_postnorm(F); STAMP(7);
#if defined(DBG_TS)
        if (blockIdx.x == 0 && threadIdx.x == 0) { asm volatile("s_waitcnt vmcnt(0)" ::: "memory"); F.out[0] += (float)(TS[DBG_TS + 1] - TS[DBG_TS]) * 0.01f; }
#endif
    }
#undef IN
#undef BOTH
}

extern "C" void kernel_launch(void* const* d_in, const int* in_sizes, int n_in, void* d_out, int out_size, void* d_ws, size_t ws_size, hipStream_t stream) {
    static int grid = 0;
    if (grid == 0) {
        if (n_in != 16 || in_sizes[0] != M * DM || out_size != M * DM || ws_size < WS_END) { fprintf(stderr, "kernel_launch: unexpected shapes (n_in %d, in0 %d, out %d, ws %zu); nothing launched\n", n_in, n_in > 0 ? in_sizes[0] : -1, out_size, ws_size); grid = -1; return; }
        int dev = 0, cus = 0, per_cu = 0;
        if (hipGetDevice(&dev) != hipSuccess || hipDeviceGetAttribute(&cus, hipDeviceAttributeMultiprocessorCount, dev) != hipSuccess) { fprintf(stderr, "kernel_launch: device query failed\n"); grid = -1; return; }
        if (hipFuncSetAttribute((const void*)hybrid_fwd, hipFuncAttributeMaxDynamicSharedMemorySize, LDS_BYTES) != hipSuccess) { fprintf(stderr, "kernel_launch: hipFuncSetAttribute failed\n"); grid = -1; return; }
        if (hipOccupancyMaxActiveBlocksPerMultiprocessor(&per_cu, (const void*)hybrid_fwd, NWAVES * 64, LDS_BYTES) != hipSuccess || per_cu < 1) { fprintf(stderr, "kernel_launch: occupancy query reports %d blocks per CU\n", per_cu); per_cu = 1; }
        (void)hipGetLastError();
        grid = cus;
        if (grid > 256) grid = 256;
    }
    if (grid < 0) return;
    if (hipMemsetAsync((char*)d_ws + WS_CTL, 0, CTL_ZERO_BYTES, stream) != hipSuccess) { fprintf(stderr, "kernel_launch: memset failed\n"); return; }
    Args a{};
    for (int i = 0; i < 16; ++i) a.in[i] = d_in[i];
    a.out = (float*)d_out; a.ws = (unsigned char*)d_ws;
    for (int i = 0; i < 32; ++i) a.invf[i] = (float)std::pow(10000.0, -(double)i / 32.0);
    for (int li = 0; li < N_LAUNCHES; ++li) {
        if (DBG_STOP >= 0 && li > DBG_STOP && li != 6) continue;
        a.ph_lo = (N_LAUNCHES == PER_PHASE) ? li : 0; a.ph_hi = (N_LAUNCHES == PER_PHASE) ? li + 1 : PER_PHASE; a.li = li;
        hipLaunchKernelGGL(hybrid_fwd, dim3(grid), dim3(NWAVES * 64), LDS_BYTES, stream, a);
        const hipError_t le = hipPeekAtLastError();
        if (le != hipSuccess) { fprintf(stderr, "kernel_launch: launch %d failed: %s\n", li, hipGetErrorName(le)); break; }
    }
}
```

```cpp
#include <hip/hip_runtime.h>
#include <cstdio>
#include <cstdint>
#include <cmath>
#ifndef MK_N_LAUNCHES
#define MK_N_LAUNCHES 1
#endif
namespace pg8 {
#define PG8_LAS __attribute__((address_space(3)))
typedef unsigned short bf16_t;
typedef short bf16x8 __attribute__((ext_vector_type(8)));
typedef float f32x4 __attribute__((ext_vector_type(4)));
typedef unsigned u32x4 __attribute__((ext_vector_type(4)));
constexpr int BM = 256, BK = 64, HALF = 128, HTB = HALF * BK * 2  , STAGE_BYTES = 8 * HTB, NXCD = 8, WGM = 8;

__host__ __device__ __forceinline__ int lds_byte(int r, int c) { const int st = (r >> 4) * 2 + (c >> 5), rr = r & 15, cc = c & 31, ob = rr * 64 + cc * 2; return st * 1024 + (ob ^ (((ob >> 9) & 1) << 5)); }
__host__ __device__ __forceinline__ void stage_rc(int b, int& R, int& C) { const int st = b / 1024, sb = b % 1024, swz = sb ^ (((sb >> 9) & 1) << 5); R = (st >> 1) * 16 + swz / 64; C = (st & 1) * 32 + (swz % 64) / 2; }
__host__ __device__ __forceinline__ int perm32(int rho) { const int n = rho >> 4, i = rho & 15; return 8 * (i >> 2) + 4 * n + (i & 3); }

struct Unit { int pm, pn; };
struct Gemm { const bf16_t* A; const bf16_t* Bt; int M, N, K; };

struct StaticOrder {
    int nM, nN, nwg, G, c;
    __host__ __device__ void init(int M, int N, int G_, int c_) { nM = M / BM; nN = N / BM; nwg = nM * nN; G = G_; c = c_; }
    __host__ __device__ bool next(int i, Unit& u) const {
        const long L = (long)i * G + c; if (L >= nwg) return false;
        int wgid = (int)L; { const int q = nwg / NXCD, r = nwg % NXCD, xcd = wgid % NXCD, off = wgid / NXCD; wgid = (xcd < r ? xcd * (q + 1) : r * (q + 1) + (xcd - r) * q) + off; }
        const int nig = WGM * nN, gid = wgid / nig, fm = gid * WGM, gsz = (nM - fm) < WGM ? (nM - fm) : WGM;
        u.pm = fm + ((wgid % nig) % gsz); u.pn = (wgid % nig) / gsz; return true;
    }
    __device__ __forceinline__ void a_ready(const Unit&) const {}
    __device__ __forceinline__ void done(const Unit&) const {}
};

typedef float f32x2c __attribute__((ext_vector_type(2))); typedef __bf16 bf16x2c __attribute__((ext_vector_type(2)));
__device__ __forceinline__ unsigned cvt_pk_bf16(float lo, float hi) { f32x2c v = {lo, hi}; bf16x2c b = __builtin_convertvector(v, bf16x2c); return __builtin_bit_cast(unsigned, b); }
typedef float f32x2 __attribute__((ext_vector_type(2)));
__device__ __forceinline__ f32x2 gelu_pk(f32x2 v) {
    const f32x2 av = __builtin_elementwise_abs(v), d = av * 0.2316418882f + 1.0f;
    f32x2 t; t.x = __builtin_amdgcn_rcpf(d.x); t.y = __builtin_amdgcn_rcpf(d.y);
    f32x2 q = t * 0.5307027145f + (-0.7265760135f); q = q * t + 0.7107068705f; q = q * t + (-0.142248368f); q = q * t + 0.127414796f; q = q * t;
    const f32x2 s = (v * v) * (-0.72134752044f);
    f32x2 e; e.x = __builtin_amdgcn_exp2f(s.x); e.y = __builtin_amdgcn_exp2f(s.y);
    const f32x2 m = v * (q * e), r = v - m;
    f32x2 o; o.x = v.x < 0.f ? m.x : r.x; o.y = v.y < 0.f ? m.y : r.y; return o;
}

__device__ __forceinline__ float sigm(float v) { return __builtin_amdgcn_rcpf(1.0f + __builtin_amdgcn_exp2f(-1.4426950408889634f * v)); }
__device__ __forceinline__ f32x4 silu4(f32x4 v) { f32x4 o; o[0] = v[0] * sigm(v[0]); o[1] = v[1] * sigm(v[1]); o[2] = v[2] * sigm(v[2]); o[3] = v[3] * sigm(v[3]); return o; }
__device__ __forceinline__ f32x4 sigm4(f32x4 v) { f32x4 o; o[0] = sigm(v[0]); o[1] = sigm(v[1]); o[2] = sigm(v[2]); o[3] = sigm(v[3]); return o; }
__device__ __forceinline__ f32x4 gelu4(f32x4 v) { const f32x2 a = gelu_pk((f32x2){v[0], v[1]}), b = gelu_pk((f32x2){v[2], v[3]}); return (f32x4){a.x, a.y, b.x, b.y}; }
__device__ __forceinline__ u32x4 pack8(f32x4 a, f32x4 b) { u32x4 w; w.x = cvt_pk_bf16(a[0], a[1]); w.y = cvt_pk_bf16(a[2], a[3]); w.z = cvt_pk_bf16(b[0], b[1]); w.w = cvt_pk_bf16(b[2], b[3]); return w; }
__device__ __forceinline__ float bf_lo(unsigned w) { return __uint_as_float(w << 16); }
__device__ __forceinline__ float bf_hi(unsigned w) { return __uint_as_float(w & 0xffff0000u); }

constexpr float QSCALE = 0.125f * 1.4426950408889634f;

struct EpiProj {
    static constexpr bool PERM = true, AFTER_DRAIN = false, MIDK = false;
    bf16_t *QKV, *ZA, *UZ, *VG, *G; const float *COS, *SIN;
    __device__ __forceinline__ void mid(f32x4 (&)[2][2][4][2], const Unit&, int, int, int, int) const {}
    __device__ __forceinline__ void operator()(const f32x4 (&acc)[2][2][4][2], const Unit& u, int wr, int wc, int fr, int fq) const {
        asm volatile("s_nop 7\n\ts_nop 7\n\ts_nop 3" : "+v"(fr), "+v"(fq));
        const int pn = u.pn, row0 = u.pm * BM + wr * 64 + fr, p0 = wc * 32 + 8 * fq;
#if defined(DBG_TILEMASK)
        { const int ty = pn < 2 ? 0 : pn == 2 ? 1 : pn < 5 ? 2 : pn < 9 ? 3 : pn < 11 ? 4 : 5; if (!((DBG_TILEMASK >> ty) & 1)) return; }
#if defined(DBG_FIRSTONLY)
        { StaticOrder S0; S0.init(32768, 4864, (int)gridDim.x, (int)blockIdx.x); Unit u0; S0.next(DBG_FIRSTONLY, u0); if (!(u0.pm == u.pm && u0.pn == u.pn)) return; }
#endif
#endif
        if (pn < 2 || (pn == 2 && wc < 2)) {
            const int colbase = (pn < 2 ? (4 * pn + wc) * 64 : 512 + wc * 64) + 8 * fq; const float qs = pn < 2 ? QSCALE : 1.0f;
#pragma unroll
            for (int ai = 0; ai < 2; ++ai)
#pragma unroll
                for (int m = 0; m < 4; ++m) { const int row = row0 + ai * HALF + m * 16;
                    const f32x4 c0 = *(const f32x4*)(COS + (size_t)row * 32 + 8 * fq), c1 = *(const f32x4*)(COS + (size_t)row * 32 + 8 * fq + 4);
                    const f32x4 s0 = *(const f32x4*)(SIN + (size_t)row * 32 + 8 * fq), s1 = *(const f32x4*)(SIN + (size_t)row * 32 + 8 * fq + 4);
                    const f32x4 a0 = acc[ai][0][m][0], a1 = acc[ai][0][m][1], b0 = acc[ai][1][m][0], b1 = acc[ai][1][m][1];
                    const f32x4 o10 = (a0 * c0 - b0 * s0) * qs, o11 = (a1 * c1 - b1 * s1) * qs, o20 = (b0 * c0 + a0 * s0) * qs, o21 = (b1 * c1 + a1 * s1) * qs;
                    bf16_t* rp = QKV + (size_t)row * 768 + colbase;
                    *(u32x4*)rp = pack8(o10, o11); *(u32x4*)(rp + 32) = pack8(o20, o21); }
        } else if (pn == 2) {
            const int colbase = 640 + (wc - 2) * 32 + 8 * fq;
#pragma unroll
            for (int ai = 0; ai < 2; ++ai)
#pragma unroll
                for (int m = 0; m < 4; ++m) { bf16_t* rp = QKV + (size_t)(row0 + ai * HALF + m * 16) * 768 + colbase;
#pragma unroll
                    for (int bj = 0; bj < 2; ++bj) *(u32x4*)(rp + bj * 64) = pack8(acc[ai][bj][m][0], acc[ai][bj][m][1]); }
        } else if (pn < 5) {
#pragma unroll
            for (int ai = 0; ai < 2; ++ai)
#pragma unroll
                for (int m = 0; m < 4; ++m) { bf16_t* rp = ZA + (size_t)(row0 + ai * HALF + m * 16) * 512 + (pn - 3) * 256 + p0;
#pragma unroll
                    for (int bj = 0; bj < 2; ++bj) *(u32x4*)(rp + bj * HALF) = pack8(silu4(acc[ai][bj][m][0]), silu4(acc[ai][bj][m][1])); }
        } else if (pn < 9) {
#pragma unroll
            for (int ai = 0; ai < 2; ++ai)
#pragma unroll
                for (int m = 0; m < 4; ++m) { bf16_t* rp = UZ + (size_t)(row0 + ai * HALF + m * 16) * 512 + (pn - 5) * 128 + p0;
                    *(u32x4*)rp = pack8(gelu4(acc[ai][0][m][0]) * silu4(acc[ai][1][m][0]), gelu4(acc[ai][0][m][1]) * silu4(acc[ai][1][m][1])); }
        } else if (pn < 11) {
#pragma unroll
            for (int ai = 0; ai < 2; ++ai)
#pragma unroll
                for (int m = 0; m < 4; ++m) { bf16_t* rp = VG + (size_t)(row0 + ai * HALF + m * 16) * 512 + (pn - 9) * 256 + p0;
#pragma unroll
                    for (int bj = 0; bj < 2; ++bj) *(u32x4*)(rp + bj * HALF) = pack8(gelu4(acc[ai][bj][m][0]), gelu4(acc[ai][bj][m][1])); }
        } else {
#pragma unroll
            for (int ai = 0; ai < 2; ++ai)
#pragma unroll
                for (int m = 0; m < 4; ++m) { bf16_t* rp = G + (size_t)(row0 + ai * HALF + m * 16) * 2048 + (pn - 11) * 256 + p0;
#pragma unroll
                    for (int bj = 0; bj < 2; ++bj) *(u32x4*)(rp + bj * HALF) = pack8(sigm4(acc[ai][bj][m][0]), sigm4(acc[ai][bj][m][1])); }
        }
    }
};

struct EpiMerge {
    static constexpr bool PERM = true, AFTER_DRAIN = false, MIDK = true;
    const bf16_t* G; bf16_t* O;
    __device__ __forceinline__ void mid(f32x4 (&acc)[2][2][4][2], const Unit& u, int wr, int wc, int fr, int fq) const {
        asm volatile("s_nop 7\n\ts_nop 7\n\ts_nop 3" : "+v"(fr), "+v"(fq));
        const int row0 = u.pm * BM + wr * 64 + fr, col0 = u.pn * BM + wc * 32 + 8 * fq;
#pragma unroll
        for (int ai = 0; ai < 2; ++ai)
#pragma unroll
            for (int m = 0; m < 4; ++m) { const bf16_t* gp = G + (size_t)(row0 + ai * HALF + m * 16) * 2048 + col0;
#pragma unroll
                for (int bj = 0; bj < 2; ++bj) { const u32x4 ga = *(const u32x4*)(gp + bj * HALF), gb = *(const u32x4*)(gp + 1024 + bj * HALF);
                    f32x4 r0, r1;
                    r0[0] = bf_lo(ga.x) * __builtin_amdgcn_rcpf(fmaxf(bf_lo(gb.x), 1e-30f)); r0[1] = bf_hi(ga.x) * __builtin_amdgcn_rcpf(fmaxf(bf_hi(gb.x), 1e-30f));
                    r0[2] = bf_lo(ga.y) * __builtin_amdgcn_rcpf(fmaxf(bf_lo(gb.y), 1e-30f)); r0[3] = bf_hi(ga.y) * __builtin_amdgcn_rcpf(fmaxf(bf_hi(gb.y), 1e-30f));
                    r1[0] = bf_lo(ga.z) * __builtin_amdgcn_rcpf(fmaxf(bf_lo(gb.z), 1e-30f)); r1[1] = bf_hi(ga.z) * __builtin_amdgcn_rcpf(fmaxf(bf_hi(gb.z), 1e-30f));
                    r1[2] = bf_lo(ga.w) * __builtin_amdgcn_rcpf(fmaxf(bf_lo(gb.w), 1e-30f)); r1[3] = bf_hi(ga.w) * __builtin_amdgcn_rcpf(fmaxf(bf_hi(gb.w), 1e-30f));
                    acc[ai][bj][m][0] = acc[ai][bj][m][0] * r0; acc[ai][bj][m][1] = acc[ai][bj][m][1] * r1; } }
    }
    __device__ __forceinline__ void operator()(const f32x4 (&acc)[2][2][4][2], const Unit& u, int wr, int wc, int fr, int fq) const {
        asm volatile("s_nop 7\n\ts_nop 7\n\ts_nop 3" : "+v"(fr), "+v"(fq));
        const int row0 = u.pm * BM + wr * 64 + fr, col0 = u.pn * BM + wc * 32 + 8 * fq;
#pragma unroll
        for (int ai = 0; ai < 2; ++ai)
#pragma unroll
            for (int m = 0; m < 4; ++m) { const size_t row = (size_t)(row0 + ai * HALF + m * 16);
#pragma unroll
                for (int bj = 0; bj < 2; ++bj) { const u32x4 gb = *(const u32x4*)(G + row * 2048 + 1024 + col0 + bj * HALF);
                    const f32x4 g0 = (f32x4){bf_lo(gb.x), bf_hi(gb.x), bf_lo(gb.y), bf_hi(gb.y)}, g1 = (f32x4){bf_lo(gb.z), bf_hi(gb.z), bf_lo(gb.w), bf_hi(gb.w)};
                    *(u32x4*)(O + row * 1024 + col0 + bj * HALF) = pack8(acc[ai][bj][m][0] * g0, acc[ai][bj][m][1] * g1); } }
    }
};

struct EpiY {
    static constexpr bool PERM = true, AFTER_DRAIN = false, MIDK = false;
    bf16_t* O; float* RSS;
    __device__ __forceinline__ void mid(f32x4 (&)[2][2][4][2], const Unit&, int, int, int, int) const {}
    __device__ __forceinline__ void operator()(const f32x4 (&acc)[2][2][4][2], const Unit& u, int wr, int wc, int fr, int fq) const {
        asm volatile("s_nop 7\n\ts_nop 7\n\ts_nop 3" : "+v"(fr), "+v"(fq));
        const int row0 = u.pm * BM + wr * 64 + fr, col0 = u.pn * BM + wc * 32 + 8 * fq;
#pragma unroll
        for (int ai = 0; ai < 2; ++ai)
#pragma unroll
            for (int m = 0; m < 4; ++m) { const size_t row = (size_t)(row0 + ai * HALF + m * 16); float q = 0.f;
#pragma unroll
                for (int bj = 0; bj < 2; ++bj) { const f32x4 a = acc[ai][bj][m][0], b = acc[ai][bj][m][1];
                    q += (a[0] * a[0] + a[1] * a[1]) + (a[2] * a[2] + a[3] * a[3]) + (b[0] * b[0] + b[1] * b[1]) + (b[2] * b[2] + b[3] * b[3]);
                    *(u32x4*)(O + row * 1024 + col0 + bj * HALF) = pack8(a, b); }
                q += __shfl_xor(q, 16); q += __shfl_xor(q, 32);
                if (fq == 0) RSS[row * 16 + u.pn * 4 + wc] = q; }
    }
};
template <class Epi, class Sched, bool ALIGN_EPI = false, bool SP2 = false>
__device__ __forceinline__ void gemm_phase(PG8_LAS unsigned char* lds, const Gemm g, const Sched& S, const Epi& E) {
    int tid_ = threadIdx.x; asm volatile("" : "+v"(tid_));
    const int tid = tid_, wid = __builtin_amdgcn_readfirstlane(tid >> 6), lane = tid & 63, wr = wid >> 2, wc = wid & 3, fr = lane & 15, fq = lane >> 4;
    const int K = g.K, nt = K / BK;
    unsigned voffA[2], voffB[2];
#pragma unroll
    for (int i = 0; i < 2; ++i) { int R, C; stage_rc(tid * 16 + i * 8192, R, C); const int Rb = Epi::PERM ? ((R & ~31) + perm32(R & 31)) : R;
        voffA[i] = (unsigned)(R * K + C) * 2u; voffB[i] = (unsigned)(Rb * K + C) * 2u; }
    const size_t kstep = (size_t)(BK * 2);
    const size_t hstep = (size_t)HALF * K * 2;
    const size_t tstep = 2 * hstep;
    const unsigned ldsw = (unsigned)wid * 1024u;
    const int aoff = lds_byte(wr * 64 + fr, fq * 8), boff = lds_byte(wc * 32 + fr, fq * 8);
#define PG8_SA(b, h) (((b) * 2 + (h)) * HTB)
#define PG8_SB(b, h) ((4 + (b) * 2 + (h)) * HTB)
#define PG8_STAGE(bufoff, gbase, voff) do { _Pragma("unroll") for (int _i = 0; _i < 2; ++_i) \
        __builtin_amdgcn_global_load_lds((const unsigned*)((const char*)(gbase) + (voff)[_i]), (PG8_LAS unsigned*)(lds + (bufoff) + ldsw + _i * 8192), 16, 0, 0); } while (0)
#define PG8_LDA(dst, b, h) do { _Pragma("unroll") for (int m = 0; m < 4; ++m) _Pragma("unroll") for (int k = 0; k < 2; ++k) dst[m][k] = *(const PG8_LAS bf16x8*)(lds + PG8_SA(b, h) + aoff + m * 2048 + k * 1024); } while (0)
#define PG8_LDB(dst, b, h) do { _Pragma("unroll") for (int n = 0; n < 2; ++n) _Pragma("unroll") for (int k = 0; k < 2; ++k) dst[n][k] = *(const PG8_LAS bf16x8*)(lds + PG8_SB(b, h) + boff + n * 2048 + k * 1024); } while (0)
#define PG8_MMA(ai, bj, At, Bt) do { __builtin_amdgcn_s_setprio(1); _Pragma("unroll") for (int m = 0; m < 4; ++m) _Pragma("unroll") for (int n = 0; n < 2; ++n) _Pragma("unroll") for (int k = 0; k < 2; ++k) \
        acc[ai][bj][m][n] = __builtin_amdgcn_mfma_f32_16x16x32_bf16(Bt[n][k], At[m][k], acc[ai][bj][m][n], 0, 0, 0); __builtin_amdgcn_s_setprio(0); } while (0)
#define PG8_WAIT_V(n) asm volatile("s_waitcnt vmcnt(" #n ")" ::: "memory")
#define PG8_WAIT_L(n) asm volatile("s_waitcnt lgkmcnt(" #n ")" ::: "memory")
#define PG8_BAR __builtin_amdgcn_s_barrier()
#define PG8_SCHED __builtin_amdgcn_sched_barrier(0)
    Unit cur, nxt; int ui = 0;
    if (!S.next(0, cur)) return;
    f32x4 acc[2][2][4][2];
#pragma unroll
    for (int a = 0; a < 2; ++a)
#pragma unroll
        for (int b = 0; b < 2; ++b)
#pragma unroll
            for (int m = 0; m < 4; ++m)
#pragma unroll
                for (int n = 0; n < 2; ++n) acc[a][b][m][n] = (f32x4){0.f, 0.f, 0.f, 0.f};
    bf16x8 At[4][2], B0[2][2], B1[2][2];
    const char* cA = (const char*)g.A + (size_t)cur.pm * tstep; const char* cB = (const char*)g.Bt + (size_t)cur.pn * tstep;
    S.a_ready(cur);
    if constexpr (SP2) {
        PG8_STAGE(PG8_SB(0, 0), cB, voffB); PG8_STAGE(PG8_SB(0, 1), cB + hstep, voffB); PG8_STAGE(PG8_SA(0, 0), cA, voffA); PG8_STAGE(PG8_SA(0, 1), cA + hstep, voffA);
        if (wr == 1) PG8_BAR;
        PG8_WAIT_V(2); PG8_BAR;
        PG8_STAGE(PG8_SB(1, 0), cB + kstep, voffB); PG8_STAGE(PG8_SA(1, 0), cA + kstep, voffA); PG8_STAGE(PG8_SB(1, 1), cB + hstep + kstep, voffB);
        PG8_WAIT_V(6); PG8_BAR;
    } else {
        PG8_STAGE(PG8_SB(0, 0), cB, voffB); PG8_STAGE(PG8_SA(0, 0), cA, voffA); PG8_STAGE(PG8_SB(0, 1), cB + hstep, voffB); PG8_STAGE(PG8_SA(0, 1), cA + hstep, voffA);
        if (wr == 1) PG8_BAR;
        PG8_WAIT_V(4); PG8_BAR;
        PG8_STAGE(PG8_SB(1, 0), cB + kstep, voffB); PG8_STAGE(PG8_SA(1, 0), cA + kstep, voffA); PG8_STAGE(PG8_SB(1, 1), cB + hstep + kstep, voffB);
        PG8_WAIT_V(6); PG8_BAR;
    }
    for (;;) {
        const bool has_next = S.next(ui + 1, nxt);
        const char* nA = has_next ? (const char*)g.A + (size_t)nxt.pm * tstep : cA; const char* nB = has_next ? (const char*)g.Bt + (size_t)nxt.pn * tstep : cB;
        for (int t = 0; t < nt; t += 2) {
            if constexpr (Epi::MIDK) { if (t == (nt >> 1)) E.mid(acc, cur, wr, wc, fr, fq); }
            const bool last = (t == nt - 2);
            const char* a1 = cA + (size_t)(t + 1) * kstep;
            const char* a2 = last ? nA : cA + (size_t)(t + 2) * kstep; const char* b2 = last ? nB : cB + (size_t)(t + 2) * kstep;
            const char* a3 = a2 + kstep; const char* b3 = b2 + kstep;
            if (last && has_next) S.a_ready(nxt);
            if constexpr (SP2) {
            PG8_LDB(B0, 0, 0); PG8_LDB(B1, 0, 1); PG8_SCHED; PG8_LDA(At, 0, 0); PG8_STAGE(PG8_SA(1, 1), a1 + hstep, voffA);
            PG8_WAIT_V(8); PG8_WAIT_L(0); PG8_BAR; PG8_MMA(0, 0, At, B0); PG8_MMA(0, 1, At, B1); PG8_BAR; PG8_SCHED;
            PG8_LDA(At, 0, 1); PG8_STAGE(PG8_SB(0, 0), b2, voffB); PG8_STAGE(PG8_SB(0, 1), b2 + hstep, voffB); PG8_STAGE(PG8_SA(0, 0), a2, voffA);
            PG8_WAIT_V(8); PG8_WAIT_L(0); PG8_BAR; PG8_MMA(1, 0, At, B0); PG8_MMA(1, 1, At, B1); PG8_BAR; PG8_SCHED;
            PG8_LDB(B0, 1, 0); PG8_LDB(B1, 1, 1); PG8_SCHED; PG8_LDA(At, 1, 0); PG8_STAGE(PG8_SA(0, 1), a2 + hstep, voffA);
            PG8_WAIT_V(8); PG8_WAIT_L(0); PG8_BAR; PG8_MMA(0, 0, At, B0); PG8_MMA(0, 1, At, B1); PG8_BAR; PG8_SCHED;
            PG8_LDA(At, 1, 1); PG8_STAGE(PG8_SB(1, 0), b3, voffB); PG8_STAGE(PG8_SB(1, 1), b3 + hstep, voffB); PG8_STAGE(PG8_SA(1, 0), a3, voffA);
            PG8_WAIT_V(8); PG8_WAIT_L(0); PG8_BAR; PG8_MMA(1, 0, At, B0); PG8_MMA(1, 1, At, B1); PG8_BAR; PG8_SCHED;
            } else {
            PG8_LDB(B0, 0, 0); PG8_SCHED; PG8_LDA(At, 0, 0); PG8_STAGE(PG8_SA(1, 1), a1 + hstep, voffA);
            PG8_WAIT_L(8); PG8_BAR; PG8_WAIT_L(0); PG8_MMA(0, 0, At, B0); PG8_BAR; PG8_SCHED;
            PG8_LDB(B1, 0, 1); PG8_STAGE(PG8_SB(0, 0), b2, voffB);
            PG8_BAR; PG8_WAIT_L(0); PG8_MMA(0, 1, At, B1); PG8_BAR;
            PG8_LDA(At, 0, 1); PG8_STAGE(PG8_SA(0, 0), a2, voffA);
            PG8_BAR; PG8_WAIT_L(0); PG8_MMA(1, 0, At, B0); PG8_BAR; PG8_SCHED;
            PG8_STAGE(PG8_SB(0, 1), b2 + hstep, voffB);
            PG8_WAIT_V(6); PG8_BAR; PG8_MMA(1, 1, At, B1); PG8_BAR;
            PG8_LDB(B0, 1, 0); PG8_SCHED; PG8_LDA(At, 1, 0); PG8_STAGE(PG8_SA(0, 1), a2 + hstep, voffA);
            PG8_WAIT_L(8); PG8_BAR; PG8_WAIT_L(0); PG8_MMA(0, 0, At, B0); PG8_BAR; PG8_SCHED;
            PG8_LDB(B1, 1, 1); PG8_STAGE(PG8_SB(1, 0), b3, voffB);
            PG8_BAR; PG8_WAIT_L(0); PG8_MMA(0, 1, At, B1); PG8_BAR;
            PG8_LDA(At, 1, 1); PG8_STAGE(PG8_SA(1, 0), a3, voffA);
            PG8_BAR; PG8_WAIT_L(0); PG8_MMA(1, 0, At, B0); PG8_BAR; PG8_SCHED;
            PG8_STAGE(PG8_SB(1, 1), b3 + hstep, voffB);
            PG8_WAIT_V(6); PG8_BAR; PG8_MMA(1, 1, At, B1); PG8_BAR;
            }
        }
        if constexpr (ALIGN_EPI) { if (wr == 0) PG8_BAR; }
        if constexpr (!Epi::AFTER_DRAIN) { E(acc, cur, wr, wc, fr, fq); S.done(cur); }
        if (!has_next) break;
#pragma unroll
        for (int a = 0; a < 2; ++a)
#pragma unroll
            for (int b = 0; b < 2; ++b)
#pragma unroll
                for (int m = 0; m < 4; ++m)
#pragma unroll
                    for (int n = 0; n < 2; ++n) acc[a][b][m][n] = (f32x4){0.f, 0.f, 0.f, 0.f};
        cur = nxt; cA = nA; cB = nB; ++ui;
        if constexpr (ALIGN_EPI) { if (wr == 1) PG8_BAR; }
    }
    PG8_WAIT_V(0);
    if constexpr (!ALIGN_EPI) { if (wr == 0) PG8_BAR; }
    PG8_BAR;
    if constexpr (Epi::AFTER_DRAIN) { E.fused(acc, cur, wr, wc, fr, fq, lds, wid, lane); S.done(cur); }
#undef PG8_SA
#undef PG8_SB
#undef PG8_STAGE
#undef PG8_LDA
#undef PG8_LDB
#undef PG8_MMA
#undef PG8_WAIT_V
#undef PG8_WAIT_L
#undef PG8_BAR
#undef PG8_SCHED
}
}
#define GAS __attribute__((address_space(1)))
#define LAS __attribute__((address_space(3)))
typedef unsigned short bf16;
typedef unsigned v4u __attribute__((ext_vector_type(4)));
typedef float f32x4 __attribute__((ext_vector_type(4)));
typedef short bf16x8 __attribute__((ext_vector_type(8)));
typedef GAS unsigned gu32;
typedef GAS unsigned long long gu64;
#define RLX_AGENT __ATOMIC_RELAXED, __HIP_MEMORY_SCOPE_AGENT
#define LDS_WAIT() asm volatile("s_waitcnt lgkmcnt(0)" ::: "memory")
#define VM_WAIT() asm volatile("s_waitcnt vmcnt(0)" ::: "memory")
__device__ __forceinline__ unsigned long long rt() { return __builtin_amdgcn_s_memrealtime(); }
__device__ __forceinline__ unsigned f2bf(float f) { unsigned u = __builtin_bit_cast(unsigned, f); return (u + 0x7fffu + ((u >> 16) & 1u)) >> 16; }
__device__ __forceinline__ unsigned pk2(float lo, float hi) { return f2bf(lo) | (f2bf(hi) << 16); }

#define XB_TMO      128
#define XB_XCNT(j)  (256  + 64 * (j))
#define XB_XSUB(j)  (1280 + 64 * (j))
#define XB_XGEN(j)  (2304 + 64 * (j))
#define XB_TOP      3328
#define XB_TOPGEN   3392
#define XCD_BAR_WORDS 3456
#define XB_SPIN_CAP (1u << 18)

__device__ __forceinline__ unsigned xb_ld(unsigned* p)              { return __hip_atomic_load(p, __ATOMIC_RELAXED, __HIP_MEMORY_SCOPE_AGENT); }
__device__ __forceinline__ unsigned xb_add(unsigned* p, unsigned v) { return __hip_atomic_fetch_add(p, v, __ATOMIC_RELAXED, __HIP_MEMORY_SCOPE_AGENT); }
__device__ __forceinline__ unsigned xb_xcc_id() { return (unsigned)__builtin_amdgcn_s_getreg((3 << 11) | 20) & 0xFu; }
#define XB_SPIN(cond, bar) do { unsigned _sp = 0; while (cond) { __builtin_amdgcn_s_sleep(1); \
    if ((++_sp & 255u) == 0u) { if (xb_ld(&(bar)[XB_TMO])) break; if (_sp > XB_SPIN_CAP) { atomicAdd(&(bar)[XB_TMO], 1u); break; } } } } while (0)

struct XcdBarrier {
    unsigned* bar; unsigned x;
    volatile LAS unsigned* st;
};

__device__ __forceinline__ XcdBarrier xcd_barrier_post(unsigned* bar, volatile LAS unsigned* st) {
    XcdBarrier b; b.bar = bar; b.x = xb_xcc_id(); b.st = st;
    if (threadIdx.x == 0) (void)xb_add(&bar[XB_XCNT(b.x)], 1u);
    return b;
}
__device__ __forceinline__ void xcd_barrier_complete(unsigned* bar, unsigned x, unsigned& nloc, unsigned& nx) {
    const unsigned G = gridDim.x * gridDim.y * gridDim.z;
    unsigned sum, cnt, mine, sp = 0u;
    for (;;) {
        sum = 0u; cnt = 0u; mine = 0u;
#pragma unroll
        for (unsigned j = 0; j < 16; ++j) { const unsigned c = xb_ld(&bar[XB_XCNT(j)]); sum += c; cnt += (c > 0u) ? 1u : 0u; mine = (j == x) ? c : mine; }
        if (sum == G) break;
        __builtin_amdgcn_s_sleep(1);
        if ((++sp & 255u) == 0u) { if (xb_ld(&bar[XB_TMO])) break; if (sp > XB_SPIN_CAP) { atomicAdd(&bar[XB_TMO], 1u); break; } }
    }
    nloc = mine > 0u ? mine : 1u; nx = cnt > 0u ? cnt : 1u;
}

__device__ __forceinline__ void xcd_barrier(const XcdBarrier& b) {
    asm volatile("s_waitcnt vmcnt(0)" ::: "memory");
    __syncthreads();
    if (threadIdx.x == 0) {
        unsigned* bar = b.bar;
        __builtin_amdgcn_s_waitcnt(0);
        unsigned nloc = b.st[0], nx = b.st[1];
        if (nloc == 0u) { xcd_barrier_complete(bar, b.x, nloc, nx); b.st[0] = nloc; b.st[1] = nx; }
        const unsigned old = xb_add(&bar[XB_XSUB(b.x)], 1u);
        const unsigned gen = old / nloc;
        if (old + 1u == (gen + 1u) * nloc) {
            __builtin_amdgcn_fence(__ATOMIC_RELEASE, "agent");
            asm volatile("s_waitcnt vmcnt(0)" ::: "memory");
            const unsigned og = xb_add(&bar[XB_TOP], 1u);
            const unsigned tg = og / nx;
            if (og + 1u == (tg + 1u) * nx) xb_add(&bar[XB_TOPGEN], 1u);
            else XB_SPIN(xb_ld(&bar[XB_TOPGEN]) == tg, bar);
            __builtin_amdgcn_fence(__ATOMIC_ACQUIRE, "agent");
            xb_add(&bar[XB_XGEN(b.x)], 1u);
            asm volatile("s_waitcnt vmcnt(0)" ::: "memory");
        } else {
            XB_SPIN(xb_ld(&bar[XB_XGEN(b.x)]) == gen, bar);
            __builtin_amdgcn_fence(__ATOMIC_ACQUIRE, "agent");
            asm volatile("s_waitcnt vmcnt(0)" ::: "memory");
        }
    }
    __syncthreads();
}

constexpr int NWAVES = 8;
constexpr int N_LAUNCHES = MK_N_LAUNCHES;
constexpr int PER_PHASE = 7;
constexpr int BATCH = 8, SEQ = 4096, DM = 1024, M = BATCH * SEQ;
constexpr int D_IN = 4864, NBLK = M / 128;
constexpr float EPS = 1e-6f;

constexpr size_t MiB = 1u << 20;
constexpr size_t WS_CTL = 0, CTL_ZERO_BYTES = 64 * 1024;
constexpr size_t WS_WIN = 2 * MiB;
constexpr size_t WS_WP = 12 * MiB;
constexpr size_t WS_WO = 14 * MiB;
constexpr size_t WS_WS = 16 * MiB;
constexpr size_t WS_ADA = 16 * MiB + 512 * 1024;
constexpr size_t WS_COS = 18 * MiB, WS_SIN = 22 * MiB;
constexpr size_t WS_RSS = 26 * MiB;
constexpr size_t WS_H = 32 * MiB;
constexpr size_t WS_QKV = 96 * MiB;
constexpr size_t WS_ZA = 144 * MiB;
constexpr size_t WS_UZ = 176 * MiB;
constexpr size_t WS_VG = 208 * MiB;
constexpr size_t WS_G = 240 * MiB;
constexpr size_t WS_MRG = 368 * MiB;
constexpr size_t WS_END = 432 * MiB;
constexpr int CW_BAR = 1024;

constexpr int RING_OFF = 0, RING_BYTES = 131072;
constexpr int LDSCTL_OFF = 143360, MISC_OFF = LDSCTL_OFF + 320;
constexpr int LDS_BYTES = 147456;

struct Frame {
    LAS unsigned char* lds;
    volatile LAS unsigned* MISC;
    gu32* ctl;
    int tid, lane, wave;
    int vcu, G;
    const float *x, *c, *w_ada, *b_ada, *g_pre, *g_post, *w_in, *sinks, *ln_g, *ln_b, *w_s, *b_s, *w_pa, *w_pb, *w_out;
    const int* pos;
    float* out;
    bf16 *WinT, *WpT, *WoT, *WsB, *H, *QKV, *ZA, *UZ, *VG, *GT, *MRG;
    float *ADA, *COS, *SIN, *RSS;
};

__device__ __forceinline__ float wave_sum(float v) {
#pragma unroll
    for (int o = 1; o < 64; o <<= 1) v += __shfl_xor(v, o);
    return v;
}
__device__ __forceinline__ float bfl(unsigned w) { return __uint_as_float(w << 16); }
__device__ __forceinline__ float bfh(unsigned w) { return __uint_as_float(w & 0xffff0000u); }
__device__ __forceinline__ float sigmf(float v) { return __builtin_amdgcn_rcpf(1.0f + __builtin_amdgcn_exp2f(-1.4426950408889634f * v)); }

__device__ __forceinline__ int proj_logical_col(int np) {
    const int pn = np >> 8, p = np & 255, bj = p >> 7, w = (p >> 5) & 3, dd = p & 31;
    if (pn < 2) return (4 * pn + w) * 64 + bj * 32 + dd;
    if (pn == 2) return w < 2 ? 512 + w * 64 + bj * 32 + dd : 640 + bj * 64 + (w - 2) * 32 + dd;
    if (pn < 5) return 768 + (pn - 3) * 256 + p;
    if (pn < 9) return (bj == 0 ? 1280 : 2304) + (pn - 5) * 128 + (p & 127);
    if (pn < 11) return 1792 + (pn - 9) * 256 + p;
    return 2816 + (pn - 11) * 256 + p;
}

__device__ __forceinline__ void p0_transpose_item(const float* W, int Nsrc, int k0, int csrc, bf16* WT, int ldk, int ndst, int kdst, LAS float* scr, int lane) {
#pragma unroll
    for (int i = 0; i < 32; ++i) { const int kk = 2 * i + (lane >> 5); scr[kk * 33 + (lane & 31)] = W[(size_t)(k0 + kk) * Nsrc + csrc + (lane & 31)]; }
    LDS_WAIT(); asm volatile("" ::: "memory");
    const int c = lane & 7;
#pragma unroll
    for (int j = 0; j < 4; ++j) { const int n = (lane >> 3) + 8 * j; const LAS float* s = scr + (8 * c) * 33 + n;
        v4u o; o.x = pk2(s[0 * 33], s[1 * 33]); o.y = pk2(s[2 * 33], s[3 * 33]); o.z = pk2(s[4 * 33], s[5 * 33]); o.w = pk2(s[6 * 33], s[7 * 33]);
        *(GAS v4u*)(WT + (size_t)(ndst + n) * ldk + kdst + 8 * c) = o; }
    LDS_WAIT(); asm volatile("" ::: "memory");
}

__device__ __forceinline__ void sincos_acc(float a, float& s, float& c) {
    const double x = (double)a;
    const double kd = rint(x * 0.63661977236758134);
    double r = fma(-kd, 1.5707963267948966, x); r = fma(-kd, 6.123233995736766e-17, r);
    const int q = ((int)kd) & 3;
    const double r2 = r * r;
    const double sp = r * (1.0 + r2 * (-1.0 / 6.0 + r2 * (1.0 / 120.0 + r2 * (-1.0 / 5040.0 + r2 * (1.0 / 362880.0 + r2 * (-1.0 / 39916800.0))))));
    const double cp = 1.0 + r2 * (-0.5 + r2 * (1.0 / 24.0 + r2 * (-1.0 / 720.0 + r2 * (1.0 / 40320.0 + r2 * (-1.0 / 3628800.0 + r2 * (1.0 / 479001600.0))))));
    const double ss = (q & 1) ? cp : sp, cc = (q & 1) ? sp : cp;
    s = (float)((q & 2) ? -ss : ss);
    c = (float)(((q + 1) & 2) ? -cc : cc);
}

__device__ __forceinline__ void p0_prologue(Frame& F, const float* invf  ) {
    const int gw = F.vcu * NWAVES + F.wave, NGW = F.G * NWAVES;
    {
        LAS float* cs = (LAS float*)(F.lds);
        LAS float* red = (LAS float*)(F.lds + 32768);
        for (int i = F.tid; i < BATCH * DM; i += NWAVES * 64) { const float v = F.c[i]; cs[i] = v * sigmf(v); }
        __syncthreads();
        for (int cb = F.vcu; cb < 256; cb += F.G) {
            const int j = F.tid % 12, kg = F.tid / 12;
            float a[BATCH];
#pragma unroll
            for (int b = 0; b < BATCH; ++b) a[b] = 0.f;
            if (kg < 42) { float w[25];
#pragma unroll
                for (int i = 0; i < 25; ++i) { const int k = kg + 42 * i; w[i] = k < DM ? F.w_ada[(size_t)k * 3072 + cb * 12 + j] : 0.f; }
#pragma unroll
                for (int i = 0; i < 25; ++i) { const int k = kg + 42 * i; if (k < DM) {
#pragma unroll
                    for (int b = 0; b < BATCH; ++b) a[b] += cs[b * DM + k] * w[i]; } } }
            if (kg < 42) {
#pragma unroll
                for (int b = 0; b < BATCH; ++b) red[(kg * 12 + j) * 8 + b] = a[b]; }
            __syncthreads();
            if (F.tid < 96) { const int jj = F.tid >> 3, b = F.tid & 7; float s = 0.f;
                for (int g = 0; g < 42; ++g) s += red[(g * 12 + jj) * 8 + b];
                F.ADA[b * 3072 + cb * 12 + jj] = s + F.b_ada[cb * 12 + jj]; }
            __syncthreads();
        }
    }
    {
        LAS float* scr = (LAS float*)(F.lds + RING_OFF + F.wave * 16384);
        constexpr int I_IN = 16 * (D_IN / 32), I_P = 8 * 32, I_O = 16 * 32;
        constexpr int NITEMS = I_IN + 2 * I_P + I_O;
        for (int it = gw; it < NITEMS; it += NGW) {
            int r = it;
            if (r < I_IN) { const int nb = r % (D_IN / 32), kb = r / (D_IN / 32); p0_transpose_item(F.w_in, D_IN, 64 * kb, proj_logical_col(32 * nb), F.WinT, 1024, 32 * nb, 64 * kb, scr, F.lane); continue; } r -= I_IN;
            if (r < I_P) { const int nb = r % 32, kb = r / 32; p0_transpose_item(F.w_pa, 1024, 64 * kb, 32 * nb, F.WpT, 1024, 32 * nb, 64 * kb, scr, F.lane); continue; } r -= I_P;
            if (r < I_P) { const int nb = r % 32, kb = r / 32; p0_transpose_item(F.w_pb, 1024, 64 * kb, 32 * nb, F.WpT, 1024, 32 * nb, 512 + 64 * kb, scr, F.lane); continue; } r -= I_P;
            { const int nb = r % 32, kb = r / 32; p0_transpose_item(F.w_out, 1024, 64 * kb, 32 * nb, F.WoT, 1024, 32 * nb, 64 * kb, scr, F.lane); }
        }
    }
    const int gt = F.vcu * (NWAVES * 64) + F.tid, NGT = F.G * NWAVES * 64;
    for (int i = gt; i < 4 * 128 * 128; i += NGT) { const int s = i & 127, t = (i >> 7) & 127; F.WsB[i] = (bf16)(s <= t ? f2bf(F.w_s[i]) : 0u); }
    for (int i = gt; i < M * 32; i += NGT) { const int tok = i >> 5, fi = i & 31; const float ang = (float)F.pos[tok] * invf[fi]; float s, c; sincos_acc(ang, s, c); F.COS[i] = c; F.SIN[i] = s; }
}

__device__ __forceinline__ void p1_prenorm(Frame& F) {
    const int gw = F.vcu * NWAVES + F.wave, NGW = F.G * NWAVES;
    for (int m0 = gw * 16; m0 < M; m0 += NGW * 16) {
        const int b = m0 / SEQ;
        f32x4 ca[4], cb[4];
#pragma unroll
        for (int j = 0; j < 4; ++j) { const int col = 4 * F.lane + 256 * j;
            ca[j] = *(const f32x4*)(F.g_pre + col) * (*(const f32x4*)(F.ADA + b * 3072 + 1024 + col) + 1.0f); cb[j] = *(const f32x4*)(F.ADA + b * 3072 + col); }
#pragma unroll 1
        for (int r0 = 0; r0 < 16; r0 += 4) {
            f32x4 v[4][4];
#pragma unroll
            for (int r = 0; r < 4; ++r) { const GAS f32x4* xr = (const GAS f32x4*)(F.x + (size_t)(m0 + r0 + r) * DM) + F.lane;
#pragma unroll
                for (int j = 0; j < 4; ++j) v[r][j] = __builtin_nontemporal_load(xr + 64 * j); }
#pragma unroll
            for (int r = 0; r < 4; ++r) { float s2 = 0.f;
#pragma unroll
                for (int j = 0; j < 4; ++j) s2 += (v[r][j].x * v[r][j].x + v[r][j].y * v[r][j].y) + (v[r][j].z * v[r][j].z + v[r][j].w * v[r][j].w);
                const float rstd = 1.f / sqrtf(wave_sum(s2) * (1.f / DM) + EPS);
                GAS unsigned long long* o8 = (GAS unsigned long long*)(F.H + (size_t)(m0 + r0 + r) * DM) + F.lane;
#pragma unroll
                for (int j = 0; j < 4; ++j) { const f32x4 h = v[r][j] * rstd * ca[j] + cb[j];
                    o8[64 * j] = (unsigned long long)pk2(h.x, h.y) | ((unsigned long long)pk2(h.z, h.w) << 32); } }
        }
    }
}

__device__ __forceinline__ void p6_postnorm(Frame& F) {
    const int gw = F.vcu * NWAVES + F.wave, NGW = F.G * NWAVES;
    for (int m0 = gw * 16; m0 < M; m0 += NGW * 16) {
        const int b = m0 / SEQ;
        f32x4 cg[4];
#pragma unroll
        for (int j = 0; j < 4; ++j) { const int col = 4 * F.lane + 256 * j; cg[j] = *(const f32x4*)(F.g_post + col) * *(const f32x4*)(F.ADA + b * 3072 + 2048 + col); }
#pragma unroll 1
        for (int r0 = 0; r0 < 16; r0 += 4) {
            f32x4 xv[4][4]; unsigned long long yw[4][4]; float part[4];
#pragma unroll
            for (int r = 0; r < 4; ++r) { const size_t m = (size_t)(m0 + r0 + r);
                part[r] = F.lane < 16 ? F.RSS[m * 16 + F.lane] : 0.f;
                const GAS f32x4* xr = (const GAS f32x4*)(F.x + m * DM) + F.lane; const GAS unsigned long long* yr = (const GAS unsigned long long*)(F.H + m * DM) + F.lane;
#pragma unroll
                for (int j = 0; j < 4; ++j) { xv[r][j] = __builtin_nontemporal_load(xr + 64 * j); yw[r][j] = yr[64 * j]; } }
#pragma unroll
            for (int r = 0; r < 4; ++r) { const float rstd = 1.f / sqrtf(wave_sum(part[r]) * (1.f / DM) + EPS);
                GAS f32x4* orow = (GAS f32x4*)(F.out + (size_t)(m0 + r0 + r) * DM) + F.lane;
#pragma unroll
                for (int j = 0; j < 4; ++j) { const unsigned long long w = yw[r][j];
                    const f32x4 y = (f32x4){bfl((unsigned)w), bfh((unsigned)w), bfl((unsigned)(w >> 32)), bfh((unsigned)(w >> 32))};
                    __builtin_nontemporal_store(xv[r][j] + cg[j] * (y * rstd), orow + 64 * j); } }
        }
    }
}

typedef float f32x16 __attribute__((ext_vector_type(16)));
typedef unsigned u32x2 __attribute__((ext_vector_type(2)));
typedef float f32x2_t __attribute__((ext_vector_type(2))); typedef __bf16 bf16x2_t __attribute__((ext_vector_type(2)));
__device__ __forceinline__ unsigned cvtpk(float lo, float hi) { f32x2_t v = {lo, hi}; bf16x2_t b = __builtin_convertvector(v, bf16x2_t); return __builtin_bit_cast(unsigned, b); }
constexpr int KS_PITCH = 144, VT_PITCH = 520, KS_BYTES = 256 * KS_PITCH, VT_OFF = KS_BYTES;
constexpr int KV_IMG = KS_BYTES + 64 * VT_PITCH;
constexpr int VN_PITCH = 272, VN_BYTES = 128 * VN_PITCH, ST_OFF = 2 * KV_IMG;

struct KVStage { v4u kv[4], vv[4]; };
__device__ __forceinline__ void kv_stage_load(Frame& F, KVStage& st, int nb, int base, int kvh) {
#pragma unroll
    for (int i = 0; i < 4; ++i) { const int id = F.tid + 512 * i, key = id >> 3, ch = id & 7; const bool ok = (nb > 0) || (key >= 128);
        const size_t row = (size_t)(base - 128 + key);
        st.kv[i] = (v4u){0u, 0u, 0u, 0u}; st.vv[i] = (v4u){0u, 0u, 0u, 0u};
        if (ok) { st.kv[i] = *(const GAS v4u*)(F.QKV + row * 768 + 512 + kvh * 64 + ch * 8); st.vv[i] = *(const GAS v4u*)(F.QKV + row * 768 + 640 + kvh * 64 + ch * 8); } }
}
__device__ __forceinline__ void kv_stage_write(Frame& F, const KVStage& st, int kvh) {
    LAS unsigned char* Ks = F.lds + kvh * KV_IMG; LAS unsigned char* Vt = Ks + VT_OFF;
#pragma unroll
    for (int i = 0; i < 4; ++i) { const int id = F.tid + 512 * i, key = id >> 3, ch = id & 7; const v4u vv = st.vv[i];
        *(LAS v4u*)(Ks + key * KS_PITCH + ch * 16) = st.kv[i];
        LAS unsigned short* vp = (LAS unsigned short*)(Vt + (ch * 8) * VT_PITCH + key * 2);
        vp[0 * (VT_PITCH / 2)] = (unsigned short)(vv.x & 0xffffu); vp[1 * (VT_PITCH / 2)] = (unsigned short)(vv.x >> 16);
        vp[2 * (VT_PITCH / 2)] = (unsigned short)(vv.y & 0xffffu); vp[3 * (VT_PITCH / 2)] = (unsigned short)(vv.y >> 16);
        vp[4 * (VT_PITCH / 2)] = (unsigned short)(vv.z & 0xffffu); vp[5 * (VT_PITCH / 2)] = (unsigned short)(vv.z >> 16);
        vp[6 * (VT_PITCH / 2)] = (unsigned short)(vv.w & 0xffffu); vp[7 * (VT_PITCH / 2)] = (unsigned short)(vv.w >> 16); }
}
__device__ __forceinline__ void attn_tile(Frame& F, int nb, int qi, int hq, size_t row, const bf16x8 (&qf)[4]) {
    const int lane = F.lane, q = lane & 31, h = lane >> 5;
    const LAS unsigned char* Ks = F.lds + (hq >> 2) * KV_IMG; const LAS unsigned char* Vt = Ks + VT_OFF;
    const float sink2 = F.sinks[hq] * 1.4426950408889634f;
    f32x16 S[5];
#pragma unroll
    for (int kt = 0; kt < 5; ++kt) {
        f32x16 a = (f32x16){0.f, 0.f, 0.f, 0.f, 0.f, 0.f, 0.f, 0.f, 0.f, 0.f, 0.f, 0.f, 0.f, 0.f, 0.f, 0.f};
#pragma unroll
        for (int ks = 0; ks < 4; ++ks) { const bf16x8 kf = *(const LAS bf16x8*)(Ks + (32 * (qi + kt) + q) * KS_PITCH + (16 * ks + 8 * h) * 2);
            a = __builtin_amdgcn_mfma_f32_32x32x16_bf16(kf, qf[ks], a, 0, 0, 0); }
        S[kt] = a; __builtin_amdgcn_sched_barrier(0); }
    float mx = sink2;
#pragma unroll
    for (int kt = 0; kt < 5; ++kt) { const bool tile_ok = (nb > 0) || (qi + kt >= 4);
#pragma unroll
        for (int r = 0; r < 16; ++r) { const int krow = (r & 3) + 8 * (r >> 2) + 4 * h; const int jrel = 32 * kt + krow - q;
            const bool ok = tile_ok && (jrel > 0) && (jrel <= 128);
            S[kt][r] = ok ? S[kt][r] : -INFINITY; mx = fmaxf(mx, S[kt][r]); } }
    mx = fmaxf(mx, __shfl_xor(mx, 32));
    float ls = 0.f;
#pragma unroll
    for (int kt = 0; kt < 5; ++kt)
#pragma unroll
        for (int r = 0; r < 16; ++r) { const float p = __builtin_amdgcn_exp2f(S[kt][r] - mx); S[kt][r] = p; ls += p; }
    ls += __shfl_xor(ls, 32);
    const float rl = 1.0f / (ls + __builtin_amdgcn_exp2f(sink2 - mx));
    u32x2 za[8];
#pragma unroll
    for (int i = 0; i < 8; ++i) za[i] = *(const GAS u32x2*)(F.ZA + row * 512 + hq * 64 + 32 * (i >> 2) + 8 * (i & 3) + 4 * h);
    f32x16 O[2];
#pragma unroll
    for (int dt = 0; dt < 2; ++dt) O[dt] = (f32x16){0.f, 0.f, 0.f, 0.f, 0.f, 0.f, 0.f, 0.f, 0.f, 0.f, 0.f, 0.f, 0.f, 0.f, 0.f, 0.f};
#pragma unroll
    for (int kt = 0; kt < 5; ++kt)
#pragma unroll
        for (int s = 0; s < 2; ++s) {
            v4u pw; pw.x = cvtpk(S[kt][8 * s + 0], S[kt][8 * s + 1]); pw.y = cvtpk(S[kt][8 * s + 2], S[kt][8 * s + 3]); pw.z = cvtpk(S[kt][8 * s + 4], S[kt][8 * s + 5]); pw.w = cvtpk(S[kt][8 * s + 6], S[kt][8 * s + 7]);
            const bf16x8 pf = __builtin_bit_cast(bf16x8, pw);
#pragma unroll
            for (int dt = 0; dt < 2; ++dt) { const LAS unsigned char* vp = Vt + (32 * dt + q) * VT_PITCH + (32 * (qi + kt) + 16 * s + 4 * h) * 2;
                const u32x2 lo = *(const LAS u32x2*)vp, hi = *(const LAS u32x2*)(vp + 16);
                const v4u vw = (v4u){lo.x, lo.y, hi.x, hi.y};
                O[dt] = __builtin_amdgcn_mfma_f32_32x32x16_bf16(__builtin_bit_cast(bf16x8, vw), pf, O[dt], 0, 0, 0); }
            __builtin_amdgcn_sched_barrier(0); }
#pragma unroll
    for (int dt = 0; dt < 2; ++dt)
#pragma unroll
        for (int r4 = 0; r4 < 4; ++r4) { const int d0 = 32 * dt + 8 * r4 + 4 * h; const u32x2 zw = za[dt * 4 + r4];
            u32x2 ow; ow.x = cvtpk(O[dt][4 * r4 + 0] * rl * bfl(zw.x), O[dt][4 * r4 + 1] * rl * bfh(zw.x)); ow.y = cvtpk(O[dt][4 * r4 + 2] * rl * bfl(zw.y), O[dt][4 * r4 + 3] * rl * bfh(zw.y));
            *(GAS u32x2*)(F.H + row * 1024 + hq * 64 + d0) = ow; }
}
__device__ __forceinline__ void attn_load_q(Frame& F, size_t row, int hq, bf16x8 (&qf)[4]) {
    const int h = F.lane >> 5;
#pragma unroll
    for (int ks = 0; ks < 4; ++ks) qf[ks] = *(const GAS bf16x8*)(F.QKV + row * 768 + hq * 64 + 16 * ks + 8 * h);
}

__device__ __forceinline__ void mixers_block(Frame& F, int blk) {
    { int t_ = threadIdx.x; asm volatile("" : "+v"(t_)); F.tid = t_; F.lane = t_ & 63; }
    const int nb = blk & 31, base = blk * 128, lane = F.lane;
    LAS float* ST = (LAS float*)(F.lds + ST_OFF);
    { { KVStage s0; kv_stage_load(F, s0, nb, base, 0); kv_stage_write(F, s0, 0); }
      asm volatile("" ::: "memory");
      { KVStage s1; kv_stage_load(F, s1, nb, base, 1); kv_stage_write(F, s1, 1); }
      asm volatile("" ::: "memory");
      v4u w[16];
#pragma unroll
      for (int i = 0; i < 16; ++i) w[i] = *(const GAS v4u*)(F.VG + (size_t)(base + 16 * F.wave + i) * 512 + 8 * lane);
#pragma unroll
      for (int i = 0; i < 16; ++i) { const int tk = 16 * F.wave + i;
        const float v0 = bfl(w[i].x), v1 = bfh(w[i].x), v2 = bfl(w[i].y), v3 = bfh(w[i].y), v4 = bfl(w[i].z), v5 = bfh(w[i].z), v6 = bfl(w[i].w), v7 = bfh(w[i].w);
        const float mean = wave_sum(((v0 + v1) + (v2 + v3)) + ((v4 + v5) + (v6 + v7))) * (1.f / 512.f);
        const float d0 = v0 - mean, d1 = v1 - mean, d2 = v2 - mean, d3 = v3 - mean, d4 = v4 - mean, d5 = v5 - mean, d6 = v6 - mean, d7 = v7 - mean;
        const float var = wave_sum(((d0 * d0 + d1 * d1) + (d2 * d2 + d3 * d3)) + ((d4 * d4 + d5 * d5) + (d6 * d6 + d7 * d7))) * (1.f / 512.f);
        if (lane == 0) { ST[2 * tk] = mean; ST[2 * tk + 1] = 1.f / sqrtf(var + EPS); } } }
    { const int g = F.wave >> 1, qi0 = 2 * (F.wave & 1);
      const size_t row0 = (size_t)(base + 32 * qi0 + (lane & 31)), row1 = row0 + 32;
      bf16x8 qa[4], qb[4];
      attn_load_q(F, row0, g, qa);
      __syncthreads();
      attn_load_q(F, row1, g, qb);     attn_tile(F, nb, qi0, g, row0, qa);
      attn_load_q(F, row0, 4 + g, qa); attn_tile(F, nb, qi0 + 1, g, row1, qb);
      attn_load_q(F, row1, 4 + g, qb); attn_tile(F, nb, qi0, 4 + g, row0, qa);
      attn_tile(F, nb, qi0 + 1, 4 + g, row1, qb);
      __syncthreads(); }
#pragma unroll 1
    for (int gp = 0; gp < 2; ++gp) {
        const int g2w = F.wave >> 2, cj = F.wave & 3, gw_ = 2 * gp + g2w, t = lane & 31, h = lane >> 5;
        { const int g2 = F.tid >> 8, co = (F.tid >> 4) & 15, so = F.tid & 15, ch0 = (2 * gp + g2) * 128 + 8 * co;
            const f32x4 ga = *(const f32x4*)(F.ln_g + ch0), gb = *(const f32x4*)(F.ln_g + ch0 + 4), ba = *(const f32x4*)(F.ln_b + ch0), bb = *(const f32x4*)(F.ln_b + ch0 + 4);
            v4u wv[8];
#pragma unroll
            for (int i = 0; i < 8; ++i) wv[i] = *(const GAS v4u*)(F.VG + (size_t)(base + 8 * so + i) * 512 + ch0);
            float vn[8][8];
#pragma unroll
            for (int i = 0; i < 8; ++i) { const int tk = 8 * so + i; const v4u w = wv[i];
                const float mean = ST[2 * tk], rstd = ST[2 * tk + 1];
                vn[i][0] = (bfl(w.x) - mean) * rstd * ga[0] + ba[0]; vn[i][1] = (bfh(w.x) - mean) * rstd * ga[1] + ba[1]; vn[i][2] = (bfl(w.y) - mean) * rstd * ga[2] + ba[2]; vn[i][3] = (bfh(w.y) - mean) * rstd * ga[3] + ba[3];
                vn[i][4] = (bfl(w.z) - mean) * rstd * gb[0] + bb[0]; vn[i][5] = (bfh(w.z) - mean) * rstd * gb[1] + bb[1]; vn[i][6] = (bfl(w.w) - mean) * rstd * gb[2] + bb[2]; vn[i][7] = (bfh(w.w) - mean) * rstd * gb[3] + bb[3]; }
            LAS unsigned char* dst = F.lds + g2 * VN_BYTES + (8 * co) * VN_PITCH + so * 16;
#pragma unroll
            for (int cc = 0; cc < 8; ++cc) { v4u o; o.x = cvtpk(vn[0][cc], vn[1][cc]); o.y = cvtpk(vn[2][cc], vn[3][cc]); o.z = cvtpk(vn[4][cc], vn[5][cc]); o.w = cvtpk(vn[6][cc], vn[7][cc]);
                *(LAS v4u*)(dst + cc * VN_PITCH) = o; } }
        asm volatile("" ::: "memory");
        bf16x8 wf[20];
        { const bf16* wp = F.WsB + (size_t)gw_ * 16384 + (size_t)t * 128 + 8 * h; int n = 0;
#pragma unroll
          for (int ks = 0; ks < 8; ++ks)
#pragma unroll
            for (int ti = 0; ti < 4; ++ti) if (2 * (ti + 1) > ks) { wf[n] = *(const GAS bf16x8*)(wp + (size_t)ti * 4096 + 16 * ks); ++n; } }
        u32x2 uz[16]; float bs[4];
#pragma unroll
        for (int ti = 0; ti < 4; ++ti) { const int tk = 32 * ti + t; bs[ti] = F.b_s[gw_ * 128 + tk];
#pragma unroll
            for (int r4 = 0; r4 < 4; ++r4) uz[ti * 4 + r4] = *(const GAS u32x2*)(F.UZ + (size_t)(base + tk) * 512 + gw_ * 128 + 32 * cj + 8 * r4 + 4 * h); }
        __syncthreads();
        { f32x16 acc[4];
#pragma unroll
            for (int ti = 0; ti < 4; ++ti) acc[ti] = (f32x16){0.f, 0.f, 0.f, 0.f, 0.f, 0.f, 0.f, 0.f, 0.f, 0.f, 0.f, 0.f, 0.f, 0.f, 0.f, 0.f};
            const LAS unsigned char* ap = F.lds + g2w * VN_BYTES + (32 * cj + t) * VN_PITCH + 16 * h; int n = 0;
#pragma unroll
            for (int ks = 0; ks < 8; ++ks) { const bf16x8 af = *(const LAS bf16x8*)(ap + 32 * ks);
#pragma unroll
                for (int ti = 0; ti < 4; ++ti) if (2 * (ti + 1) > ks) { acc[ti] = __builtin_amdgcn_mfma_f32_32x32x16_bf16(af, wf[n], acc[ti], 0, 0, 0); ++n; } }
#pragma unroll
            for (int ti = 0; ti < 4; ++ti) { const size_t row = (size_t)(base + 32 * ti + t);
#pragma unroll
                for (int r4 = 0; r4 < 4; ++r4) { const int c0 = gw_ * 128 + 32 * cj + 8 * r4 + 4 * h; const u32x2 uw = uz[ti * 4 + r4];
                    u32x2 ow; ow.x = cvtpk((acc[ti][4 * r4 + 0] + bs[ti]) * bfl(uw.x), (acc[ti][4 * r4 + 1] + bs[ti]) * bfh(uw.x)); ow.y = cvtpk((acc[ti][4 * r4 + 2] + bs[ti]) * bfl(uw.y), (acc[ti][4 * r4 + 3] + bs[ti]) * bfh(uw.y));
                    *(GAS u32x2*)(F.H + row * 1024 + 512 + c0) = ow; } } }
        __syncthreads();
    }
}

__device__ __forceinline__ void naive_mixers(Frame& F, int blk) {
    const int nb = blk & 31, base = blk * 128, lane = F.lane;
    for (int it = F.wave; it < 128 * 8; it += NWAVES) { const int i = it >> 3, hq = it & 7, kvh = hq >> 2; const size_t row = (size_t)(base + i);
        const float qd = bfl((unsigned)F.QKV[row * 768 + hq * 64 + lane]);
        const float sink2 = F.sinks[hq] * 1.4426950408889634f;
        float m = sink2, l = 1.0f, o = 0.f;
        int j0 = i - 127; if (nb == 0 && j0 < 0) j0 = 0;
        for (int j = j0; j <= i; ++j) { const size_t kr = (size_t)(base + j);
            const float s = wave_sum(qd * bfl((unsigned)F.QKV[kr * 768 + 512 + kvh * 64 + lane]));
            const float mn = fmaxf(m, s), sc = exp2f(m - mn), p = exp2f(s - mn);
            l = l * sc + p; o = o * sc + p * bfl((unsigned)F.QKV[kr * 768 + 640 + kvh * 64 + lane]); m = mn; }
        const float y = o / l * bfl((unsigned)F.ZA[row * 512 + hq * 64 + lane]);
        F.H[row * 1024 + hq * 64 + lane] = (bf16)f2bf(y); }
    LAS float* ST = (LAS float*)(F.lds);
    __syncthreads();
    if (F.tid < 128) { const size_t row = (size_t)(base + F.tid); float s = 0.f; for (int c = 0; c < 512; ++c) s += bfl((unsigned)F.VG[row * 512 + c]);
        const float mean = s / 512.f; float q = 0.f; for (int c = 0; c < 512; ++c) { const float dlt = bfl((unsigned)F.VG[row * 512 + c]) - mean; q += dlt * dlt; }
        ST[2 * F.tid] = mean; ST[2 * F.tid + 1] = 1.f / sqrtf(q / 512.f + EPS); }
    __syncthreads();
    for (int it = F.tid; it < 128 * 512; it += NWAVES * 64) { const int t = it >> 9, ch = it & 511, g = ch >> 7; float acc = 0.f;
        for (int s = 0; s <= t; ++s) { const float vn = (bfl((unsigned)F.VG[(size_t)(base + s) * 512 + ch]) - ST[2 * s]) * ST[2 * s + 1] * F.ln_g[ch] + F.ln_b[ch];
            acc += F.w_s[(g * 128 + t) * 128 + s] * vn; }
        const float y = (acc + F.b_s[g * 128 + t]) * bfl((unsigned)F.UZ[(size_t)(base + t) * 512 + ch]);
        F.H[(size_t)(base + t) * 1024 + 512 + ch] = (bf16)f2bf(y); }
    __syncthreads();
}

__device__ __forceinline__ float naive_dot_in(Frame& F, size_t row, int c) { float a = 0.f; for (int k = 0; k < DM; ++k) a += bfl((unsigned)F.H[row * 1024 + k]) * F.w_in[(size_t)k * D_IN + c]; return a; }
__device__ __forceinline__ float gelu_exact(float v) { return 0.5f * v * (1.0f + erff(v * 0.70710678118654752f)); }
__device__ __forceinline__ void naive_proj(Frame& F) {
    const size_t gt = (size_t)F.vcu * (NWAVES * 64) + F.tid, NGT = (size_t)F.G * NWAVES * 64;
    for (size_t it = gt; it < (size_t)M * 4352; it += NGT) { const size_t row = it / 4352; const int j = (int)(it % 4352);
        if (j < 640) { const int d = j & 63, dd = d & 31; const int c1 = (j & ~63) + dd, c2 = c1 + 32;
            const float t1 = naive_dot_in(F, row, c1), t2 = naive_dot_in(F, row, c2), cs = F.COS[row * 32 + dd], sn = F.SIN[row * 32 + dd];
            float o = d < 32 ? t1 * cs - t2 * sn : t2 * cs + t1 * sn; if (j < 512) o *= 0.125f * 1.4426950408889634f;
            F.QKV[row * 768 + j] = (bf16)f2bf(o); }
        else if (j < 768) F.QKV[row * 768 + j] = (bf16)f2bf(naive_dot_in(F, row, j));
        else if (j < 1280) { const float v = naive_dot_in(F, row, j); F.ZA[row * 512 + (j - 768)] = (bf16)f2bf(v * sigmf(v)); }
        else if (j < 1792) { const float u = naive_dot_in(F, row, j), z = naive_dot_in(F, row, j + 1024); F.UZ[row * 512 + (j - 1280)] = (bf16)f2bf(gelu_exact(u) * z * sigmf(z)); }
        else if (j < 2304) { const float v = naive_dot_in(F, row, j); F.VG[row * 512 + (j - 1792)] = (bf16)f2bf(gelu_exact(v)); }
        else { const float v = naive_dot_in(F, row, j + 512); F.GT[row * 2048 + (j - 2304)] = (bf16)f2bf(sigmf(v)); } }
}
__device__ __forceinline__ void naive_merge(Frame& F) {
    const size_t gt = (size_t)F.vcu * (NWAVES * 64) + F.tid, NGT = (size_t)F.G * NWAVES * 64;
    for (size_t it = gt; it < (size_t)M * DM; it += NGT) { const size_t row = it >> 10; const int n = (int)(it & 1023); float a = 0.f, b = 0.f;
        for (int k = 0; k < 512; ++k) { a += bfl((unsigned)F.H[row * 1024 + k]) * F.w_pa[(size_t)k * 1024 + n]; b += bfl((unsigned)F.H[row * 1024 + 512 + k]) * F.w_pb[(size_t)k * 1024 + n]; }
        F.MRG[it] = (bf16)f2bf(bfl((unsigned)F.GT[row * 2048 + n]) * a + bfl((unsigned)F.GT[row * 2048 + 1024 + n]) * b); }
}
__device__ __forceinline__ void naive_out(Frame& F) {
    LAS float* red = (LAS float*)F.lds;
    for (int row = F.vcu; row < M; row += F.G) { float q = 0.f;
        for (int n = F.tid; n < DM; n += NWAVES * 64) { float a = 0.f; for (int k = 0; k < DM; ++k) a += bfl((unsigned)F.MRG[(size_t)row * 1024 + k]) * F.w_out[(size_t)k * 1024 + n];
            F.H[(size_t)row * 1024 + n] = (bf16)f2bf(a); q += a * a; }
        q = wave_sum(q); if (F.lane == 0) red[F.wave] = q; __syncthreads();
        if (F.tid < 16) F.RSS[(size_t)row * 16 + F.tid] = F.tid == 0 ? ((red[0] + red[1]) + (red[2] + red[3])) + ((red[4] + red[5]) + (red[6] + red[7])) : 0.f;
        __syncthreads(); }
}

struct Args { const void* in[16]; float* out; unsigned char* ws; float invf[32]; int ph_lo, ph_hi, li, pad; };

typedef const __attribute__((address_space(4))) Args* KArgs;
__device__ __forceinline__ void fresh_tid(Frame& F) { int t = threadIdx.x; asm volatile("" : "+v"(t)); F.tid = t; F.lane = t & 63; }
__device__ __forceinline__ KArgs fresh_args() { KArgs p = (KArgs)__builtin_amdgcn_kernarg_segment_ptr(); asm volatile("" : "+s"(p)); return p; }
__device__ __forceinline__ void fill_frame(Frame& F, KArgs a) {
    unsigned char* ws = a->ws;
    F.x = (const float*)a->in[0]; F.c = (const float*)a->in[1]; F.pos = (const int*)a->in[2]; F.w_ada = (const float*)a->in[3]; F.b_ada = (const float*)a->in[4];
    F.g_pre = (const float*)a->in[5]; F.g_post = (const float*)a->in[6]; F.w_in = (const float*)a->in[7]; F.sinks = (const float*)a->in[8];
    F.ln_g = (const float*)a->in[9]; F.ln_b = (const float*)a->in[10]; F.w_s = (const float*)a->in[11]; F.b_s = (const float*)a->in[12];
    F.w_pa = (const float*)a->in[13]; F.w_pb = (const float*)a->in[14]; F.w_out = (const float*)a->in[15]; F.out = a->out;
    F.WinT = (bf16*)(ws + WS_WIN); F.WpT = (bf16*)(ws + WS_WP); F.WoT = (bf16*)(ws + WS_WO); F.WsB = (bf16*)(ws + WS_WS);
    F.H = (bf16*)(ws + WS_H); F.QKV = (bf16*)(ws + WS_QKV); F.ZA = (bf16*)(ws + WS_ZA); F.UZ = (bf16*)(ws + WS_UZ); F.VG = (bf16*)(ws + WS_VG); F.GT = (bf16*)(ws + WS_G); F.MRG = (bf16*)(ws + WS_MRG);
    F.ADA = (float*)(ws + WS_ADA); F.COS = (float*)(ws + WS_COS); F.SIN = (float*)(ws + WS_SIN); F.RSS = (float*)(ws + WS_RSS);
}

#ifndef DBG_STOP
#define DBG_STOP -1
#endif
__device__ __forceinline__ float bf2f(bf16 v) { return __uint_as_float((unsigned)v << 16); }
__device__ __forceinline__ void dbg_dump(Frame& F) {
    const size_t gt = (size_t)F.vcu * (NWAVES * 64) + F.tid, NGT = (size_t)F.G * NWAVES * 64, NOUT = (size_t)M * DM;
    for (size_t i = gt; i < NOUT; i += NGT) {
        float v = 0.f;
        if (DBG_STOP == 0) v = bf2f(F.WinT[i % ((size_t)D_IN * 1024)]) + bf2f(F.WpT[i % (1024 * 1024)]) + bf2f(F.WoT[i % (1024 * 1024)]) + bf2f(F.WsB[i % 65536]) + F.ADA[i % 24576] + F.COS[i % ((size_t)M * 32)] + F.SIN[i % ((size_t)M * 32)];
        if (DBG_STOP == 1 || DBG_STOP == 3) v = bf2f(F.H[i]);
        if (DBG_STOP == 2) v = bf2f(F.GT[2 * i]) + 2.f * bf2f(F.GT[2 * i + 1]) + bf2f(F.QKV[i % ((size_t)M * 768)]) + bf2f(F.ZA[i % ((size_t)M * 512)]) + bf2f(F.UZ[i % ((size_t)M * 512)]) + bf2f(F.VG[i % ((size_t)M * 512)]);
        if (DBG_STOP == 4) v = bf2f(F.MRG[i]);
        if (DBG_STOP == 5) v = bf2f(F.H[i]) + F.RSS[i % ((size_t)M * 16)];
        F.out[i] = v;
    }
}
__global__ void __launch_bounds__(NWAVES * 64, 2) hybrid_fwd(Args args) {
    extern __shared__ __attribute__((aligned(16))) unsigned char lds[];
    Frame F;
    F.lds = (LAS unsigned char*)lds;
    F.MISC = (volatile LAS unsigned*)(F.lds + MISC_OFF);
    F.tid = threadIdx.x; F.lane = F.tid & 63; F.wave = __builtin_amdgcn_readfirstlane(F.tid >> 6);
    F.G = gridDim.x; { const int bx = blockIdx.x; F.vcu = (F.G % 8 == 0) ? (bx % 8) * (F.G / 8) + bx / 8 : bx; }
    F.ctl = (gu32*)(args.ws + WS_CTL);
    for (int u = F.tid; u < (LDS_BYTES - LDSCTL_OFF) / 4; u += NWAVES * 64) ((LAS unsigned*)(F.lds + LDSCTL_OFF))[u] = 0u;
    __syncthreads();
    if (F.tid < 32) ((LAS float*)(F.lds + LDSCTL_OFF + 1024))[F.tid] = args.invf[F.tid];
    __syncthreads();
    XcdBarrier bar; bar.bar = (unsigned*)(F.ctl + CW_BAR); bar.x = 0; bar.st = nullptr;
    if (N_LAUNCHES != PER_PHASE) bar = xcd_barrier_post((unsigned*)(F.ctl + CW_BAR), F.MISC + 8);
#define GRID_BAR() do { if (N_LAUNCHES != PER_PHASE) xcd_barrier(bar); } while (0)
#if defined(DBG_TS)
    volatile LAS unsigned long long* TS = (volatile LAS unsigned long long*)(F.lds + LDSCTL_OFF + 2048);
#define STAMP(k) do { if (blockIdx.x == 0 && threadIdx.x == 0) TS[k] = __builtin_amdgcn_s_memrealtime(); } while (0)
#else
#define STAMP(k) do { } while (0)
#endif
    STAMP(0);
    const int lo = args.ph_lo, hi = args.ph_hi;
#define IN(k) (lo <= (k) && (k) < hi)
#define BOTH(k) (IN(k) && IN((k) + 1))
    if (IN(0)) { fill_frame(F, fresh_args()); fresh_tid(F); p0_prologue(F, (const float*)(lds + LDSCTL_OFF + 1024)); if (BOTH(0)) GRID_BAR(); STAMP(1); }
    if (IN(1)) { fill_frame(F, fresh_args()); fresh_tid(F); p1_prenorm(F); if (BOTH(1)) GRID_BAR(); STAMP(2); }
    if (IN(2)) { fill_frame(F, fresh_args()); fresh_tid(F);
#if defined(NAIVE_P2)
        naive_proj(F);
#endif
#if defined(DBG_TILEMASK)
        GRID_BAR();
#endif
#if !defined(NAIVE_P2) || defined(DBG_TILEMASK)
        pg8::Gemm g{F.H, F.WinT, M, D_IN, DM}; pg8::StaticOrder S; S.init(M, D_IN, F.G, (int)blockIdx.x);
        pg8::EpiProj E{F.QKV, F.ZA, F.UZ, F.VG, F.GT, F.COS, F.SIN};
        pg8::gemm_phase<pg8::EpiProj, pg8::StaticOrder, true, true>(F.lds + RING_OFF, g, S, E);
#endif
        if (BOTH(2)) GRID_BAR(); STAMP(3);
    }
    if (IN(3)) { fill_frame(F, fresh_args()); fresh_tid(F);
#if defined(NAIVE_P3)
        for (int blk = F.vcu; blk < NBLK; blk += F.G) naive_mixers(F, blk);
#else
        for (int blk = F.vcu; blk < NBLK; blk += F.G) mixers_block(F, blk);
#endif
        if (BOTH(3)) GRID_BAR(); STAMP(4);
    }
    if (IN(4)) { fill_frame(F, fresh_args()); fresh_tid(F);
#if defined(NAIVE_P45)
        naive_merge(F);
#else
        pg8::Gemm g{F.H, F.WpT, M, DM, DM}; pg8::StaticOrder S; S.init(M, DM, F.G, (int)blockIdx.x);
        pg8::EpiMerge E{F.GT, F.MRG};
        pg8::gemm_phase<pg8::EpiMerge, pg8::StaticOrder, true, true>(F.lds + RING_OFF, g, S, E);
#endif
        if (BOTH(4)) GRID_BAR(); STAMP(5);
    }
    if (IN(5)) { fill_frame(F, fresh_args()); fresh_tid(F);
#if defined(NAIVE_P45)
        naive_out(F);
#else
        pg8::Gemm g{F.MRG, F.WoT, M, DM, DM}; pg8::StaticOrder S; S.init(M, DM, F.G, (int)blockIdx.x);
        pg8::EpiY E{F.H, F.RSS};
        pg8::gemm_phase<pg8::EpiY, pg8::StaticOrder, true, true>(F.lds + RING_OFF, g, S, E);
#endif
        if (BOTH(5)) GRID_BAR(); STAMP(6);
    }
    if (IN(6)) { fill_frame(F, fresh_args()); fresh_tid(F); if (DBG_STOP >= 0) dbg_dump(F); else p6_postnorm(F); STAMP(7);
#if defined(DBG_TS)
        if (blockIdx.x == 0 && threadIdx.x == 0) { asm volatile("s_waitcnt vmcnt(0)" ::: "memory"); F.out[0] += (float)(TS[DBG_TS + 1] - TS[DBG_TS]) * 0.01f; }
#endif
    }
#undef IN
#undef BOTH
}

extern "C" void kernel_launch(void* const* d_in, const int* in_sizes, int n_in, void* d_out, int out_size, void* d_ws, size_t ws_size, hipStream_t stream) {
    static int grid = 0;
    if (grid == 0) {
        if (n_in != 16 || in_sizes[0] != M * DM || out_size != M * DM || ws_size < WS_END) { fprintf(stderr, "kernel_launch: unexpected shapes (n_in %d, in0 %d, out %d, ws %zu); nothing launched\n", n_in, n_in > 0 ? in_sizes[0] : -1, out_size, ws_size); grid = -1; return; }
        int dev = 0, cus = 0, per_cu = 0;
        if (hipGetDevice(&dev) != hipSuccess || hipDeviceGetAttribute(&cus, hipDeviceAttributeMultiprocessorCount, dev) != hipSuccess) { fprintf(stderr, "kernel_launch: device query failed\n"); grid = -1; return; }
        if (hipFuncSetAttribute((const void*)hybrid_fwd, hipFuncAttributeMaxDynamicSharedMemorySize, LDS_BYTES) != hipSuccess) { fprintf(stderr, "kernel_launch: hipFuncSetAttribute failed\n"); grid = -1; return; }
        if (hipOccupancyMaxActiveBlocksPerMultiprocessor(&per_cu, (const void*)hybrid_fwd, NWAVES * 64, LDS_BYTES) != hipSuccess || per_cu < 1) { fprintf(stderr, "kernel_launch: occupancy query reports %d blocks per CU\n", per_cu); per_cu = 1; }
        (void)hipGetLastError();
        grid = cus;
        if (grid > 256) grid = 256;
    }
    if (grid < 0) return;
    if (hipMemsetAsync((char*)d_ws + WS_CTL, 0, CTL_ZERO_BYTES, stream) != hipSuccess) { fprintf(stderr, "kernel_launch: memset failed\n"); return; }
    Args a{};
    for (int i = 0; i < 16; ++i) a.in[i] = d_in[i];
    a.out = (float*)d_out; a.ws = (unsigned char*)d_ws;
    for (int i = 0; i < 32; ++i) a.invf[i] = (float)std::pow(10000.0, -(double)i / 32.0);
    for (int li = 0; li < N_LAUNCHES; ++li) {
        if (DBG_STOP >= 0 && li > DBG_STOP && li != 6) continue;
        a.ph_lo = (N_LAUNCHES == PER_PHASE) ? li : 0; a.ph_hi = (N_LAUNCHES == PER_PHASE) ? li + 1 : PER_PHASE; a.li = li;
        hipLaunchKernelGGL(hybrid_fwd, dim3(grid), dim3(NWAVES * 64), LDS_BYTES, stream, a);
        const hipError_t le = hipPeekAtLastError();
        if (le != hipSuccess) { fprintf(stderr, "kernel_launch: launch %d failed: %s\n", li, hipGetErrorName(le)); break; }
    }
}
```
